# Optimizing an MI355X kernel written in HIP

```python
import math
import jax, jax.numpy as jnp
from jax import lax
import numpy as np

D_MODEL = 1024
BATCH = 4
SEQ = 4096
DEPTH = 2


CHUNK = 64
HEAD_DIM = 64
FOX_HEADS = D_MODEL // HEAD_DIM
FOX_BLOCK = 128
SWA_Q_HEADS = D_MODEL // HEAD_DIM
SWA_KV_HEADS = 4
SWA_GROUP = SWA_Q_HEADS // SWA_KV_HEADS
WINDOW = 128
WINDOW_CHUNKS = WINDOW // CHUNK
BAND = (WINDOW_CHUNKS + 1) * CHUNK
REL_BUCKETS = 32
REL_MAX_DIST = 128
D_FF = 7 * D_MODEL // 2
N_EXPERTS = 8
TOP_K = 2
N_MOD = 6
EPS = 1e-6
N_EVEN = (DEPTH + 1) // 2
N_ODD = DEPTH // 2

kernel_name = "hybrid_fox_swa_sink_moe_adaln"


def rmsnorm(x, g):
    xf = x.astype(jnp.float32)
    y = xf * lax.rsqrt(jnp.mean(xf * xf, axis=-1, keepdims=True) + EPS)
    return (y * g.astype(jnp.float32)).astype(x.dtype)


def modulate(h, shift, scale):
    return h * (1.0 + scale[:, None, :]) + shift[:, None, :]


def t5_band_buckets():
    q = np.arange(CHUNK)[:, None]
    k = np.arange(BAND)[None, :] - WINDOW_CHUNKS * CHUNK
    rel = k - q
    nb = REL_BUCKETS // 2
    max_exact = nb // 2
    ret = (rel > 0).astype(np.int32) * nb
    n = np.abs(rel)
    large = max_exact + (np.log(np.maximum(n, 1) / max_exact)
                         / np.log(REL_MAX_DIST / max_exact) * (nb - max_exact)).astype(np.int32)
    large = np.minimum(large, nb - 1)
    return (ret + np.where(n < max_exact, n, large)).astype(np.int32)


def fox_attention(xn, w_in, b_f, w_out):
    B, S, D = xn.shape
    H, Dh = FOX_HEADS, HEAD_DIM
    q, k, v, f_logit = jnp.split(xn @ w_in, [D, 2 * D, 3 * D], axis=-1)
    q = q.reshape(B, S, H, Dh) * (Dh ** -0.5)
    k = k.reshape(B, S, H, Dh)
    v = v.reshape(B, S, H, Dh)
    log_f = jax.nn.log_sigmoid(f_logit.astype(jnp.float32) + b_f.astype(jnp.float32))
    cum = jnp.cumsum(log_f, axis=1).transpose(0, 2, 1)
    outs = []
    for blk in range(S // FOX_BLOCK):
        q0, q1 = blk * FOX_BLOCK, (blk + 1) * FOX_BLOCK
        s = jnp.einsum('bqhd,bkhd->bhqk', q[:, q0:q1], k[:, :q1]).astype(jnp.float32)
        s = s + cum[:, :, q0:q1, None] - cum[:, :, None, :q1]
        causal = jnp.arange(q1)[None, :] <= jnp.arange(q0, q1)[:, None]
        s = jnp.where(causal, s, -jnp.inf)
        p = jax.nn.softmax(s, axis=-1).astype(v.dtype)
        outs.append(jnp.einsum('bhqk,bkhd->bqhd', p, v[:, :q1]))
    o = jnp.concatenate(outs, axis=1).reshape(B, S, D)
    return o @ w_out


def swa_sink_attention(xn, w_in, sinks, rel_table, w_out):
    B, S, D = xn.shape
    Hk, G, Dh = SWA_KV_HEADS, SWA_GROUP, HEAD_DIM
    nC = S // CHUNK
    kvw = Hk * Dh
    q, k, v = jnp.split(xn @ w_in, [D, D + kvw], axis=-1)
    q = q.reshape(B, nC, CHUNK, Hk, G, Dh) * (Dh ** -0.5)

    def band(t):
        t = t.reshape(B, S, Hk, Dh)
        t = jnp.pad(t, ((0, 0), (WINDOW_CHUNKS * CHUNK, 0), (0, 0), (0, 0)))
        t = t.reshape(B, nC + WINDOW_CHUNKS, CHUNK, Hk, Dh)
        return jnp.concatenate([t[:, j:j + nC] for j in range(WINDOW_CHUNKS + 1)], axis=2)

    kb, vb = band(k), band(v)
    s = jnp.einsum('bcqhgd,bckhd->bchgqk', q, kb).astype(jnp.float32)
    bias = rel_table[t5_band_buckets()]
    bias = bias.transpose(2, 0, 1).reshape(Hk, G, CHUNK, BAND).astype(jnp.float32)
    s = s + bias
    kpos = (jnp.arange(nC)[:, None] * CHUNK - WINDOW_CHUNKS * CHUNK
            + jnp.arange(BAND)[None, :])
    s = jnp.where((kpos >= 0)[None, :, None, None, None, :], s, -jnp.inf)
    sink = sinks.astype(jnp.float32).reshape(1, 1, Hk, G, 1, 1)
    m = jnp.maximum(jnp.max(s, axis=-1, keepdims=True), sink)
    p = jnp.exp(s - m)
    p = p / (jnp.sum(p, axis=-1, keepdims=True) + jnp.exp(sink - m))
    o = jnp.einsum('bchgqk,bckhd->bcqhgd', p.astype(vb.dtype), vb).reshape(B, S, D)
    return o @ w_out


def swiglu(h, w_gu, w_down):
    g, u = jnp.split(h @ w_gu, 2, axis=-1)
    return (jax.nn.silu(g) * u) @ w_down


def moe_swiglu(xn, w_router, b_router, w_gu, w_down):
    B, S, D = xn.shape
    xt = xn.reshape(B * S, D)
    logits = (xt @ w_router).astype(jnp.float32) + b_router.astype(jnp.float32)
    top_val, top_idx = lax.top_k(logits, TOP_K)
    top_w = jax.nn.softmax(top_val, axis=-1)
    gates = jnp.sum(jax.nn.one_hot(top_idx, N_EXPERTS, dtype=jnp.float32) * top_w[..., None],
                    axis=1).astype(xt.dtype)
    out = jnp.zeros_like(xt)
    for e in range(N_EXPERTS):
        out = out + gates[:, e:e + 1] * swiglu(xt, w_gu[e], w_down[e])
    return out.reshape(B, S, D)


def setup_inputs(seed: int = 0) -> dict:
    key = jax.random.key(seed)
    ks = jax.random.split(key, 20)
    D, F, E = D_MODEL, D_FF, N_EXPERTS
    kvw = SWA_KV_HEADS * HEAD_DIM
    nrm = jax.random.normal
    sd = D ** -0.5
    sf = F ** -0.5
    return {
        "x": nrm(ks[0], (BATCH, SEQ, D), jnp.float32),
        "c": nrm(ks[1], (BATCH, D), jnp.float32),
        "w_ada": nrm(ks[2], (DEPTH, D, N_MOD * D), jnp.float32) * (0.5 * sd),
        "b_ada": nrm(ks[3], (DEPTH, N_MOD * D), jnp.float32) * 0.02,
        "g_norm_mix": 1.0 + 0.05 * nrm(ks[4], (DEPTH, D), jnp.float32),
        "g_norm_ffn": 1.0 + 0.05 * nrm(ks[5], (DEPTH, D), jnp.float32),
        "g_final": 1.0 + 0.05 * nrm(ks[6], (D,), jnp.float32),
        "fox_w_in": nrm(ks[7], (N_EVEN, D, 3 * D + FOX_HEADS), jnp.float32) * sd,
        "fox_b_f": 2.0 + 0.5 * nrm(ks[8], (N_EVEN, FOX_HEADS), jnp.float32),
        "fox_w_out": nrm(ks[9], (N_EVEN, D, D), jnp.float32) * sd,
        "swa_w_in": nrm(ks[10], (N_ODD, D, D + 2 * kvw), jnp.float32) * sd,
        "swa_sinks": 0.5 * nrm(ks[11], (N_ODD, SWA_Q_HEADS), jnp.float32),
        "swa_w_out": nrm(ks[12], (N_ODD, D, D), jnp.float32) * sd,
        "rel_bias": 0.5 * nrm(ks[13], (REL_BUCKETS, SWA_Q_HEADS), jnp.float32),
        "ffn_w_gu": nrm(ks[14], (N_EVEN, D, 2 * F), jnp.float32) * sd,
        "ffn_w_down": nrm(ks[15], (N_EVEN, F, D), jnp.float32) * sf,
        "moe_w_router": nrm(ks[16], (N_ODD, D, E), jnp.float32) * sd,
        "moe_b_router": 0.01 * nrm(ks[17], (N_ODD, E), jnp.float32),
        "moe_w_gu": nrm(ks[18], (N_ODD, E, D, 2 * F), jnp.float32) * sd,
        "moe_w_down": nrm(ks[19], (N_ODD, E, F, D), jnp.float32) * sf,
    }


def reference(x, c, w_ada, b_ada, g_norm_mix, g_norm_ffn, g_final,
              fox_w_in, fox_b_f, fox_w_out,
              swa_w_in, swa_sinks, swa_w_out, rel_bias,
              ffn_w_gu, ffn_w_down,
              moe_w_router, moe_b_router, moe_w_gu, moe_w_down):
    cond = jax.nn.silu(c)
    for i in range(DEPTH):
        j = i // 2
        mod = cond @ w_ada[i] + b_ada[i]
        sh1, sc1, gt1, sh2, sc2, gt2 = jnp.split(mod, N_MOD, axis=-1)
        h = modulate(rmsnorm(x, g_norm_mix[i]), sh1, sc1)
        if i % 2 == 0:
            y = fox_attention(h, fox_w_in[j], fox_b_f[j], fox_w_out[j])
        else:
            y = swa_sink_attention(h, swa_w_in[j], swa_sinks[j], rel_bias, swa_w_out[j])
        x = x + gt1[:, None, :] * y
        h = modulate(rmsnorm(x, g_norm_ffn[i]), sh2, sc2)
        if i % 2 == 0:
            y = swiglu(h, ffn_w_gu[j], ffn_w_down[j])
        else:
            y = moe_swiglu(h, moe_w_router[j], moe_b_router[j], moe_w_gu[j], moe_w_down[j])
        x = x + gt2[:, None, :] * y
    return rmsnorm(x, g_final)
```

```cpp
#include <hip/hip_runtime.h>
#include <cstdio>
#include <cstdint>

namespace {
constexpr int D = 1024, NB = 4, S = 4096, NTOK = NB * S, F = 3584, NE = 8, NH = 16, HD = 64;
constexpr int FOXN = 3 * D + NH;
constexpr int SWAN = D + 2 * 256;
typedef short bf16x8 __attribute__((ext_vector_type(8)));
typedef float f32x4 __attribute__((ext_vector_type(4)));

__device__ __forceinline__ unsigned short f2bf(float f) { unsigned u = __builtin_bit_cast(unsigned, f); return (unsigned short)((u + 0x7fffu + ((u >> 16) & 1u)) >> 16); }
__device__ __forceinline__ float siluf(float v) { return v / (1.f + __expf(-v)); }
__device__ __forceinline__ float wave_sum(float v) {
#pragma unroll
    for (int o = 1; o < 64; o <<= 1) v += __shfl_xor(v, o);
    return v;
}

__global__ void k_ada(const float* __restrict__ c, const float* __restrict__ w, const float* __restrict__ bias, float* __restrict__ mod) {
    const int idx = blockIdx.x * blockDim.x + threadIdx.x;
    if (idx >= 2 * 6144) return;
    const int l = idx / 6144, n = idx % 6144;
    float a0 = 0, a1 = 0, a2 = 0, a3 = 0;
    const float* wp = w + (size_t)l * D * 6144 + n;
    for (int k = 0; k < D; ++k) {
        const float wv = wp[(size_t)k * 6144];
        a0 += siluf(c[k]) * wv; a1 += siluf(c[D + k]) * wv; a2 += siluf(c[2 * D + k]) * wv; a3 += siluf(c[3 * D + k]) * wv;
    }
    const float bv = bias[l * 6144 + n];
    mod[(l * 4 + 0) * 6144 + n] = a0 + bv; mod[(l * 4 + 1) * 6144 + n] = a1 + bv;
    mod[(l * 4 + 2) * 6144 + n] = a2 + bv; mod[(l * 4 + 3) * 6144 + n] = a3 + bv;
}

__global__ void k_normmod(const float* __restrict__ x, const float* __restrict__ g, const float* __restrict__ shift, const float* __restrict__ scale, float* __restrict__ h) {
    const int row = blockIdx.x * (blockDim.x / 64) + (threadIdx.x >> 6), lane = threadIdx.x & 63;
    if (row >= NTOK) return;
    const int b = row / S;
    const float* xr = x + (size_t)row * D;
    float v[16]; float s = 0.f;
#pragma unroll
    for (int j = 0; j < 16; ++j) { v[j] = xr[lane + 64 * j]; s += v[j] * v[j]; }
    s = wave_sum(s);
    const float r = rsqrtf(s * (1.f / D) + 1e-6f);
#pragma unroll
    for (int j = 0; j < 16; ++j) { const int cidx = lane + 64 * j; float y = v[j] * r * g[cidx];
        if (shift) y = y * (1.f + scale[(size_t)b * 6144 + cidx]) + shift[(size_t)b * 6144 + cidx];
        h[(size_t)row * D + cidx] = y; }
}

__global__ void __launch_bounds__(256) k_gemm(const float* __restrict__ A, int lda, const int* __restrict__ arows, const int* __restrict__ mcount, int M,
                                              const float* __restrict__ B, int ldb, float* __restrict__ C, int ldc, int N, int K) {
    __shared__ __attribute__((aligned(16))) unsigned short sA[64][40];
    __shared__ __attribute__((aligned(16))) unsigned short sB[64][40];
    const int Mr = mcount ? *mcount : M;
    const int m0 = blockIdx.y * 64, n0 = blockIdx.x * 64;
    if (m0 >= Mr) return;
    const int tid = threadIdx.x, lane = tid & 63, w = tid >> 6;
    const int ar = tid >> 2, ak = (tid & 3) * 8;
    const bool avalid = (m0 + ar) < Mr;
    const int arow = avalid ? (arows ? arows[m0 + ar] : m0 + ar) : 0;
    const float* ap = A + (size_t)arow * lda + ak;
    const int bk = tid >> 3, bn = (tid & 7) * 8;
    const bool bvalid = (n0 + bn) < N;
    const float* bp = B + (size_t)bk * ldb + n0 + bn;
    f32x4 acc[4];
#pragma unroll
    for (int i = 0; i < 4; ++i) acc[i] = (f32x4){0.f, 0.f, 0.f, 0.f};
    for (int k0 = 0; k0 < K; k0 += 32) {
        float av[8], bv[8];
#pragma unroll
        for (int j = 0; j < 8; ++j) { av[j] = avalid ? ap[k0 + j] : 0.f; bv[j] = bvalid ? bp[(size_t)k0 * ldb + j] : 0.f; }
#pragma unroll
        for (int j = 0; j < 8; ++j) { sA[ar][ak + j] = f2bf(av[j]); sB[bn + j][bk] = f2bf(bv[j]); }
        __syncthreads();
        const bf16x8 a = *(const bf16x8*)&sA[16 * w + (lane & 15)][(lane >> 4) * 8];
#pragma unroll
        for (int nt = 0; nt < 4; ++nt) { const bf16x8 b = *(const bf16x8*)&sB[16 * nt + (lane & 15)][(lane >> 4) * 8];
            acc[nt] = __builtin_amdgcn_mfma_f32_16x16x32_bf16(a, b, acc[nt], 0, 0, 0); }
        __syncthreads();
    }
#pragma unroll
    for (int nt = 0; nt < 4; ++nt)
#pragma unroll
        for (int j = 0; j < 4; ++j) { const int r = m0 + 16 * w + (lane >> 4) * 4 + j, cc = n0 + 16 * nt + (lane & 15);
            if (r < Mr && cc < N) C[(size_t)r * ldc + cc] = acc[nt][j]; }
}

__global__ void k_fox_cum(const float* __restrict__ qkvf, const float* __restrict__ b_f, float* __restrict__ cum) {
    const int bh = blockIdx.x * blockDim.x + threadIdx.x; if (bh >= NB * NH) return;
    const int b = bh / NH, h = bh % NH; float acc = 0.f; const float bf = b_f[h];
    for (int s = 0; s < S; ++s) { const float z = qkvf[(size_t)(b * S + s) * FOXN + 3 * D + h] + bf;
        const float ls = fminf(z, 0.f) - log1pf(__expf(-fabsf(z)));
        acc += ls; cum[(size_t)bh * S + s] = acc; }
}

__global__ void __launch_bounds__(64) k_fox_attn(const float* __restrict__ qkvf, const float* __restrict__ cum, float* __restrict__ o) {
    __shared__ __attribute__((aligned(16))) float sK[64][64];
    __shared__ __attribute__((aligned(16))) float sV[64][64];
    __shared__ float sC[64];
    const int qt = blockIdx.x % 64, bh = blockIdx.x / 64, b = bh / NH, h = bh % NH, t = threadIdx.x;
    const int qrow = qt * 64 + t;
    const float* base = qkvf + (size_t)b * S * FOXN;
    float q[64], acc[64];
#pragma unroll
    for (int d = 0; d < 64; ++d) { q[d] = base[(size_t)qrow * FOXN + h * 64 + d] * 0.125f; acc[d] = 0.f; }
    const float cq = cum[(size_t)bh * S + qrow];
    float m = -INFINITY, l = 0.f;
    for (int kt = 0; kt <= qt; ++kt) {
        __syncthreads();
        for (int i = t; i < 64 * 16; i += 64) { const int r = i >> 4, c4 = (i & 15) * 4;
            *(f32x4*)&sK[r][c4] = *(const f32x4*)(base + (size_t)(kt * 64 + r) * FOXN + D + h * 64 + c4);
            *(f32x4*)&sV[r][c4] = *(const f32x4*)(base + (size_t)(kt * 64 + r) * FOXN + 2 * D + h * 64 + c4); }
        sC[t] = cum[(size_t)bh * S + kt * 64 + t];
        __syncthreads();
        const int jmax = (kt == qt) ? t : 63;
        for (int j = 0; j <= jmax; ++j) {
            float s = 0.f;
#pragma unroll
            for (int d = 0; d < 64; ++d) s += q[d] * sK[j][d];
            s += cq - sC[j];
            const float mn = fmaxf(m, s), al = __expf(m - mn), p = __expf(s - mn);
            l = l * al + p; m = mn;
#pragma unroll
            for (int d = 0; d < 64; ++d) acc[d] = acc[d] * al + p * sV[j][d];
        }
    }
    const float inv = 1.f / l;
#pragma unroll
    for (int d = 0; d < 64; ++d) o[(size_t)(b * S + qrow) * D + h * 64 + d] = acc[d] * inv;
}

__device__ __forceinline__ int t5_bucket(int rel) {
    const int n = rel < 0 ? -rel : rel;
    const int v = n < 8 ? n : 8 + (n >= 12) + (n >= 16) + (n >= 23) + (n >= 32) + (n >= 46) + (n >= 64) + (n >= 91);
    return (rel > 0 ? 16 : 0) + v;
}

__global__ void __launch_bounds__(64) k_swa_attn(const float* __restrict__ qkv, const float* __restrict__ sinks, const float* __restrict__ rel_bias, float* __restrict__ o) {
    __shared__ __attribute__((aligned(16))) float sK[64][64];
    __shared__ __attribute__((aligned(16))) float sV[64][64];
    __shared__ float sT[256];
    const int hq = blockIdx.x % NH, c = (blockIdx.x / NH) % 64, b = blockIdx.x / (NH * 64), t = threadIdx.x, hk = hq / 4;
    for (int i = t; i < 255; i += 64) sT[i] = rel_bias[t5_bucket(i - 191) * NH + hq];
    const int qrow = c * 64 + t;
    const float* base = qkv + (size_t)b * S * SWAN;
    float q[64], acc[64];
#pragma unroll
    for (int d = 0; d < 64; ++d) { q[d] = base[(size_t)qrow * SWAN + hq * 64 + d] * 0.125f; acc[d] = 0.f; }
    float m = -INFINITY, l = 0.f;
    for (int kc = 0; kc < 3; ++kc) {
        const int kch = c - 2 + kc; if (kch < 0) continue;
        __syncthreads();
        for (int i = t; i < 64 * 16; i += 64) { const int r = i >> 4, c4 = (i & 15) * 4;
            *(f32x4*)&sK[r][c4] = *(const f32x4*)(base + (size_t)(kch * 64 + r) * SWAN + D + hk * 64 + c4);
            *(f32x4*)&sV[r][c4] = *(const f32x4*)(base + (size_t)(kch * 64 + r) * SWAN + D + 256 + hk * 64 + c4); }
        __syncthreads();
        for (int j = 0; j < 64; ++j) {
            float s = 0.f;
#pragma unroll
            for (int d = 0; d < 64; ++d) s += q[d] * sK[j][d];
            const int rel = (kc * 64 + j - 128) - t;
            s += sT[rel + 191];
            const float mn = fmaxf(m, s), al = __expf(m - mn), p = __expf(s - mn);
            l = l * al + p; m = mn;
#pragma unroll
            for (int d = 0; d < 64; ++d) acc[d] = acc[d] * al + p * sV[j][d];
        }
    }
    const float sk = sinks[hq], mf = fmaxf(m, sk), al = __expf(m - mf);
    l = l * al + __expf(sk - mf);
    const float inv = al / l;
#pragma unroll
    for (int d = 0; d < 64; ++d) o[(size_t)(b * S + qrow) * D + hq * 64 + d] = acc[d] * inv;
}

__global__ void k_resid(const float* __restrict__ xin, const float* __restrict__ gate, const float* __restrict__ y, float* __restrict__ xout) {
    const size_t i = (size_t)blockIdx.x * blockDim.x + threadIdx.x; if (i >= (size_t)NTOK * D) return;
    const int row = (int)(i / D), cidx = (int)(i % D), b = row / S;
    xout[i] = xin[i] + gate[(size_t)b * 6144 + cidx] * y[i];
}
__global__ void k_swiglu(float* __restrict__ G, const int* __restrict__ mcount, int M) {
    const int Mr = mcount ? *mcount : M;
    const size_t i = (size_t)blockIdx.x * blockDim.x + threadIdx.x; const int row = (int)(i / F), j = (int)(i % F);
    if (row >= Mr) return;
    float* gp = G + (size_t)row * 2 * F; gp[j] = siluf(gp[j]) * gp[F + j];
}
__global__ void k_route(const float* __restrict__ h, const float* __restrict__ wr, const float* __restrict__ br, int* __restrict__ cnt, int* __restrict__ list, float* __restrict__ wlist) {
    const int row = blockIdx.x * (blockDim.x / 64) + (threadIdx.x >> 6), lane = threadIdx.x & 63;
    if (row >= NTOK) return;
    float lg[8];
#pragma unroll
    for (int e = 0; e < 8; ++e) lg[e] = 0.f;
    for (int k = lane; k < D; k += 64) { const float hv = h[(size_t)row * D + k];
#pragma unroll
        for (int e = 0; e < 8; ++e) lg[e] += hv * wr[k * 8 + e]; }
#pragma unroll
    for (int e = 0; e < 8; ++e) lg[e] = wave_sum(lg[e]) + br[e];
    if (lane == 0) {
        int i0 = 0; float v0 = lg[0];
#pragma unroll
        for (int e = 1; e < 8; ++e) if (lg[e] > v0) { v0 = lg[e]; i0 = e; }
        int i1 = -1; float v1 = -INFINITY;
#pragma unroll
        for (int e = 0; e < 8; ++e) if (e != i0 && lg[e] > v1) { v1 = lg[e]; i1 = e; }
        const float w1 = 1.f / (1.f + __expf(v0 - v1)), w0 = 1.f - w1;
        const int p0 = atomicAdd(&cnt[i0], 1); list[i0 * NTOK + p0] = row; wlist[i0 * NTOK + p0] = w0;
        const int p1 = atomicAdd(&cnt[i1], 1); list[i1 * NTOK + p1] = row; wlist[i1 * NTOK + p1] = w1;
    }
}
__global__ void k_scatter(const float* __restrict__ y, const int* __restrict__ mcount, const int* __restrict__ list, const float* __restrict__ wlist, float* __restrict__ ysum) {
    const size_t i = (size_t)blockIdx.x * blockDim.x + threadIdx.x; const int p = (int)(i / D), cidx = (int)(i % D);
    if (p >= *mcount) return;
    ysum[(size_t)list[p] * D + cidx] += wlist[p] * y[(size_t)p * D + cidx];
}
}

extern "C" void kernel_launch(void* const* d_in, const int* in_sizes, int n_in, void* d_out, int out_size, void* d_ws, size_t ws_size, hipStream_t stream) {
    const float* x = (const float*)d_in[0]; const float* c = (const float*)d_in[1]; const float* w_ada = (const float*)d_in[2]; const float* b_ada = (const float*)d_in[3];
    const float* g_mix = (const float*)d_in[4]; const float* g_ffn = (const float*)d_in[5]; const float* g_final = (const float*)d_in[6];
    const float* fox_w_in = (const float*)d_in[7]; const float* fox_b_f = (const float*)d_in[8]; const float* fox_w_out = (const float*)d_in[9];
    const float* swa_w_in = (const float*)d_in[10]; const float* swa_sinks = (const float*)d_in[11]; const float* swa_w_out = (const float*)d_in[12]; const float* rel_bias = (const float*)d_in[13];
    const float* ffn_w_gu = (const float*)d_in[14]; const float* ffn_w_down = (const float*)d_in[15];
    const float* moe_w_router = (const float*)d_in[16]; const float* moe_b_router = (const float*)d_in[17]; const float* moe_w_gu = (const float*)d_in[18]; const float* moe_w_down = (const float*)d_in[19];
    float* out = (float*)d_out;
    constexpr size_t MiB = 1u << 20;
    char* ws = (char*)d_ws;
    int* cnt = (int*)(ws);
    float* mod = (float*)(ws + 1 * MiB);
    int* list = (int*)(ws + 2 * MiB);
    float* wlist = (float*)(ws + 3 * MiB);
    float* cum = (float*)(ws + 4 * MiB);
    float* H = (float*)(ws + 8 * MiB);
    float* O = (float*)(ws + 72 * MiB);
    float* Y = (float*)(ws + 136 * MiB);
    float* XA = (float*)(ws + 200 * MiB);
    float* YS = (float*)(ws + 264 * MiB);
    float* BIG = (float*)(ws + 328 * MiB);
    if (ws_size < 776 * MiB) { fprintf(stderr, "kernel_launch: workspace too small (%zu)\n", ws_size); return; }
    (void)hipMemsetAsync(cnt, 0, 64, stream);
    (void)hipMemsetAsync(YS, 0, (size_t)NTOK * D * 4, stream);
    k_ada<<<48, 256, 0, stream>>>(c, w_ada, b_ada, mod);
    const dim3 eb(256);
    const int ew_blocks = (int)(((size_t)NTOK * D + 255) / 256);
    const float* m0 = mod;
    k_normmod<<<NTOK / 4, 256, 0, stream>>>(x, g_mix, m0 + 0 * D, m0 + 1 * D, H);
    k_gemm<<<dim3((FOXN + 63) / 64, NTOK / 64), 256, 0, stream>>>(H, D, nullptr, nullptr, NTOK, fox_w_in, FOXN, BIG, FOXN, FOXN, D);
    k_fox_cum<<<1, 64, 0, stream>>>(BIG, fox_b_f, cum);
    k_fox_attn<<<NB * NH * 64, 64, 0, stream>>>(BIG, cum, O);
    k_gemm<<<dim3(D / 64, NTOK / 64), 256, 0, stream>>>(O, D, nullptr, nullptr, NTOK, fox_w_out, D, Y, D, D, D);
    k_resid<<<ew_blocks, eb, 0, stream>>>(x, m0 + 2 * D, Y, XA);
    k_normmod<<<NTOK / 4, 256, 0, stream>>>(XA, g_ffn, m0 + 3 * D, m0 + 4 * D, H);
    k_gemm<<<dim3(2 * F / 64, NTOK / 64), 256, 0, stream>>>(H, D, nullptr, nullptr, NTOK, ffn_w_gu, 2 * F, BIG, 2 * F, 2 * F, D);
    k_swiglu<<<(int)(((size_t)NTOK * F + 255) / 256), eb, 0, stream>>>(BIG, nullptr, NTOK);
    k_gemm<<<dim3(D / 64, NTOK / 64), 256, 0, stream>>>(BIG, 2 * F, nullptr, nullptr, NTOK, ffn_w_down, D, Y, D, D, F);
    k_resid<<<ew_blocks, eb, 0, stream>>>(XA, m0 + 5 * D, Y, XA);
    const float* m1 = mod + 4 * 6144;
    k_normmod<<<NTOK / 4, 256, 0, stream>>>(XA, g_mix + D, m1 + 0 * D, m1 + 1 * D, H);
    k_gemm<<<dim3(SWAN / 64, NTOK / 64), 256, 0, stream>>>(H, D, nullptr, nullptr, NTOK, swa_w_in, SWAN, BIG, SWAN, SWAN, D);
    k_swa_attn<<<NB * 64 * NH, 64, 0, stream>>>(BIG, swa_sinks, rel_bias, O);
    k_gemm<<<dim3(D / 64, NTOK / 64), 256, 0, stream>>>(O, D, nullptr, nullptr, NTOK, swa_w_out, D, Y, D, D, D);
    k_resid<<<ew_blocks, eb, 0, stream>>>(XA, m1 + 2 * D, Y, XA);
    k_normmod<<<NTOK / 4, 256, 0, stream>>>(XA, g_ffn + D, m1 + 3 * D, m1 + 4 * D, H);
    k_route<<<NTOK / 4, 256, 0, stream>>>(H, moe_w_router, moe_b_router, cnt, list, wlist);
    for (int e = 0; e < NE; ++e) {
        k_gemm<<<dim3(2 * F / 64, NTOK / 64), 256, 0, stream>>>(H, D, list + e * NTOK, cnt + e, NTOK, moe_w_gu + (size_t)e * D * 2 * F, 2 * F, BIG, 2 * F, 2 * F, D);
        k_swiglu<<<(int)(((size_t)NTOK * F + 255) / 256), eb, 0, stream>>>(BIG, cnt + e, NTOK);
        k_gemm<<<dim3(D / 64, NTOK / 64), 256, 0, stream>>>(BIG, 2 * F, nullptr, cnt + e, NTOK, moe_w_down + (size_t)e * F * D, D, Y, D, D, F);
        k_scatter<<<ew_blocks, eb, 0, stream>>>(Y, cnt + e, list + e * NTOK, wlist + e * NTOK, YS);
    }
    k_resid<<<ew_blocks, eb, 0, stream>>>(XA, m1 + 5 * D, YS, XA);
    k_normmod<<<NTOK / 4, 256, 0, stream>>>(XA, g_final, nullptr, nullptr, out);
}
```

```cpp
#include <hip/hip_runtime.h>
#include <cstdio>
#include <cstdint>
#include <cmath>
namespace pg8 {
#define PG8_LAS __attribute__((address_space(3)))
typedef unsigned short bf16_t;
typedef short bf16x8 __attribute__((ext_vector_type(8)));
typedef float f32x4 __attribute__((ext_vector_type(4)));
typedef unsigned u32x4 __attribute__((ext_vector_type(4)));
constexpr int BM = 256, BK = 64, HALF = 128, HTB = HALF * BK * 2  , STAGE_BYTES = 8 * HTB, NXCD = 8, WGM = 8;

__host__ __device__ __forceinline__ int lds_byte(int r, int c) { const int st = (r >> 4) * 2 + (c >> 5), rr = r & 15, cc = c & 31, ob = rr * 64 + cc * 2; return st * 1024 + (ob ^ (((ob >> 9) & 1) << 5)); }
__host__ __device__ __forceinline__ void stage_rc(int b, int& R, int& C) { const int st = b / 1024, sb = b % 1024, swz = sb ^ (((sb >> 9) & 1) << 5); R = (st >> 1) * 16 + swz / 64; C = (st & 1) * 32 + (swz % 64) / 2; }
__host__ __device__ __forceinline__ int perm32(int rho) { const int n = rho >> 4, i = rho & 15; return 8 * (i >> 2) + 4 * n + (i & 3); }
__device__ __forceinline__ int pg8_lane_id() { int l; asm volatile("v_mbcnt_lo_u32_b32 %0, -1, 0\n\tv_mbcnt_hi_u32_b32 %0, -1, %0" : "=v"(l)); return l; }
struct Unit { int pm, pn, orow, ocol, aux, mt; };
struct Gemm { const bf16_t* A; const bf16_t* Bt; int M, N, K; };

struct StaticOrder {
    int nM, nN, nwg, G, c;
    __device__ __forceinline__ void init(int M, int N, int G_, int c_) { nM = M / BM; nN = N / BM; nwg = nM * nN; G = G_; c = c_; }
    __device__ __forceinline__ bool next(int i, Unit& u) const {
        const long L = (long)i * G + c; if (L >= nwg) return false;
        int wgid = (int)L; { const int q = nwg / NXCD, r = nwg % NXCD, xcd = wgid % NXCD, off = wgid / NXCD; wgid = (xcd < r ? xcd * (q + 1) : r * (q + 1) + (xcd - r) * q) + off; }
        const int nig = WGM * nN, gid = wgid / nig, fm = gid * WGM, gsz = (nM - fm) < WGM ? (nM - fm) : WGM;
        u.pm = fm + ((wgid % nig) % gsz); u.pn = (wgid % nig) / gsz; u.orow = u.pm * BM; u.ocol = u.pn; u.aux = 0; u.mt = u.pm; return true;
    }
    __device__ __forceinline__ void a_ready(const Unit&) const {}
    __device__ __forceinline__ void done(const Unit&) const {}
};
struct MoeOrder {
    const PG8_LAS int* tab; int nN, G, c, TM, apt;
    __device__ __forceinline__ void init(const PG8_LAS int* tab_, int nN_, int G_, int c_, int apt_) { tab = tab_; nN = nN_; G = G_; c = c_; apt = apt_; TM = __builtin_amdgcn_readfirstlane(tab_[8]); }
    __device__ __forceinline__ bool next(int i, Unit& u) const {
        const int nwg = TM * nN; const long L = (long)i * G + c; if (L >= nwg) return false;
        int wgid = (int)L; { const int q = nwg / NXCD, r = nwg % NXCD, xcd = wgid % NXCD, off = wgid / NXCD; wgid = (xcd < r ? xcd * (q + 1) : r * (q + 1) + (xcd - r) * q) + off; }
        const int nig = WGM * nN, gid = wgid / nig, fm = gid * WGM, gsz = (TM - fm) < WGM ? (TM - fm) : WGM;
        const int gm = fm + ((wgid % nig) % gsz), pnl = (wgid % nig) / gsz;
        int e = 0;
#pragma unroll
        for (int j = 1; j < 8; ++j) e += (gm >= tab[j]) ? 1 : 0;
        e = __builtin_amdgcn_readfirstlane(e);
        const int t0 = __builtin_amdgcn_readfirstlane(tab[e]), mt = gm - t0;
        u.pm = apt ? e * apt + mt : t0 + mt; u.pn = e * nN + pnl; u.orow = (t0 + mt) * BM; u.ocol = pnl; u.aux = e; u.mt = mt; return true;
    }
    __device__ __forceinline__ void a_ready(const Unit&) const {}
    __device__ __forceinline__ void done(const Unit&) const {}
};

__device__ __forceinline__ unsigned cvt_pk_bf16(float lo, float hi) { unsigned r; asm volatile("v_cvt_pk_bf16_f32 %0, %1, %2" : "=v"(r) : "v"(lo), "v"(hi)); return r; }
__device__ __forceinline__ float silu_f(float v) { return v * __builtin_amdgcn_rcpf(1.0f + __builtin_amdgcn_exp2f(-1.4426950408889634f * v)); }

template <int MODE> struct EpiQKV {
    static constexpr bool PERM = true, AFTER_DRAIN = false;
    bf16_t* Q; size_t stride; float scale0;
    __device__ __forceinline__ void operator()(const f32x4 (&acc)[2][2][4][2], const Unit& u, int wr, int wc, int fr, int fq) const {
        const int pn = u.ocol; int t, ldc, colt;
        if (MODE == 0) { t = pn >> 2; ldc = 1024; colt = (pn & 3) * 256; }
        else { if (pn < 4) { t = 0; ldc = 1024; colt = pn * 256; } else { t = pn - 3; ldc = 256; colt = 0; } }
        bf16_t* base = Q + (size_t)t * stride; const float sc = (t == 0) ? scale0 : 1.f;
        const int row0 = u.orow + wr * 64 + fr, col0 = colt + wc * 32 + 8 * fq;
#pragma unroll
        for (int ai = 0; ai < 2; ++ai)
#pragma unroll
            for (int m = 0; m < 4; ++m) { bf16_t* rowp = base + (size_t)(row0 + ai * HALF + m * 16) * ldc + col0;
#pragma unroll
                for (int bj = 0; bj < 2; ++bj) { const f32x4 v0 = acc[ai][bj][m][0] * sc, v1 = acc[ai][bj][m][1] * sc;
                    u32x4 w; w.x = cvt_pk_bf16(v0[0], v0[1]); w.y = cvt_pk_bf16(v0[2], v0[3]); w.z = cvt_pk_bf16(v1[0], v1[1]); w.w = cvt_pk_bf16(v1[2], v1[3]);
                    *(u32x4*)(rowp + bj * HALF) = w; } }
    }
};
struct EpiResid {
    static constexpr bool PERM = false, AFTER_DRAIN = false;
    const float* xin; float* out; const float* gate; int ldc, rows_per_batch, gld;
    __device__ __forceinline__ void operator()(const f32x4 (&acc)[2][2][4][2], const Unit& u, int wr, int wc, int fr, int fq) const {
        const int row0 = u.orow + wr * 64 + fr, col0 = u.ocol * BM + wc * 32 + 4 * fq;
        const float* gp = gate + (size_t)(u.orow / rows_per_batch) * gld + col0;
        f32x4 gv[2][2];
#pragma unroll
        for (int bj = 0; bj < 2; ++bj)
#pragma unroll
            for (int n = 0; n < 2; ++n) gv[bj][n] = *(const f32x4*)(gp + bj * HALF + n * 16);
#pragma unroll
        for (int ai = 0; ai < 2; ++ai)
#pragma unroll
            for (int m = 0; m < 4; ++m) { const size_t off = (size_t)(row0 + ai * HALF + m * 16) * ldc + col0;
#pragma unroll
                for (int bj = 0; bj < 2; ++bj)
#pragma unroll
                    for (int n = 0; n < 2; ++n) { const f32x4 xv = *(const f32x4*)(xin + off + bj * HALF + n * 16); *(f32x4*)(out + off + bj * HALF + n * 16) = xv + gv[bj][n] * acc[ai][bj][m][n]; }
                asm volatile("" ::: "memory"); }
    }
};
struct EpiSwiglu {
    static constexpr bool PERM = true, AFTER_DRAIN = false;
    bf16_t* O; int ldc;
    __device__ __forceinline__ void operator()(const f32x4 (&acc)[2][2][4][2], const Unit& u, int wr, int wc, int fr, int fq) const {
        const int row0 = u.orow + wr * 64 + fr, col0 = u.ocol * HALF + wc * 32 + 8 * fq;
#pragma unroll
        for (int ai = 0; ai < 2; ++ai)
#pragma unroll
            for (int m = 0; m < 4; ++m) { bf16_t* rowp = O + (size_t)(row0 + ai * HALF + m * 16) * ldc + col0;
                const f32x4 g0 = acc[ai][0][m][0], g1 = acc[ai][0][m][1], u0 = acc[ai][1][m][0], u1 = acc[ai][1][m][1];
                u32x4 w; w.x = cvt_pk_bf16(silu_f(g0[0]) * u0[0], silu_f(g0[1]) * u0[1]); w.y = cvt_pk_bf16(silu_f(g0[2]) * u0[2], silu_f(g0[3]) * u0[3]);
                w.z = cvt_pk_bf16(silu_f(g1[0]) * u1[0], silu_f(g1[1]) * u1[1]); w.w = cvt_pk_bf16(silu_f(g1[2]) * u1[2], silu_f(g1[3]) * u1[3]);
                *(u32x4*)rowp = w; }
    }
};
struct EpiScatter {
    static constexpr bool PERM = true, AFTER_DRAIN = false;
    bf16_t* YS; const int* list; const float* wl; const unsigned* cnt; int lpitch, cstride;
    __device__ __forceinline__ void operator()(const f32x4 (&acc)[2][2][4][2], const Unit& u, int wr, int wc, int fr, int fq) const {
        const int e = u.aux, ne = (int)cnt[e * cstride], p0 = u.mt * BM + wr * 64 + fr, col0 = u.ocol * BM + wc * 32 + 8 * fq;
#pragma unroll
        for (int ai = 0; ai < 2; ++ai)
#pragma unroll
            for (int m = 0; m < 4; ++m) { const int p = p0 + ai * HALF + m * 16;
                if (p < ne) { const int t2 = list[e * lpitch + p]; const float w = wl[e * lpitch + p]; bf16_t* rowp = YS + (size_t)t2 * 1024 + col0;
#pragma unroll
                    for (int bj = 0; bj < 2; ++bj) { const f32x4 v0 = acc[ai][bj][m][0] * w, v1 = acc[ai][bj][m][1] * w;
                        u32x4 q; q.x = cvt_pk_bf16(v0[0], v0[1]); q.y = cvt_pk_bf16(v0[2], v0[3]); q.z = cvt_pk_bf16(v1[0], v1[1]); q.w = cvt_pk_bf16(v1[2], v1[3]);
                        *(u32x4*)(rowp + bj * HALF) = q; } } }
    }
};

template <class Epi, class Sched, bool ALIGN_EPI = false, bool SP2 = false>
__device__ __forceinline__ void gemm_phase(PG8_LAS unsigned char* lds, const Gemm g, const Sched& S, const Epi& E, const int wid) {
    const int lane = pg8_lane_id(), tid = wid * 64 + lane, wr = wid >> 2, wc = wid & 3, fr = lane & 15, fq = lane >> 4;
    const int K = g.K, nt = K / BK;
    unsigned voffA[2], voffB[2];
#pragma unroll
    for (int i = 0; i < 2; ++i) { int R, C; stage_rc(tid * 16 + i * 8192, R, C); const int Rb = Epi::PERM ? ((R & ~31) + perm32(R & 31)) : R;
        voffA[i] = (unsigned)(R * K + C) * 2u; voffB[i] = (unsigned)(Rb * K + C) * 2u; }
    const size_t kstep = (size_t)(BK * 2);
    const size_t hstep = (size_t)HALF * K * 2;
    const size_t tstep = 2 * hstep;
    const unsigned ldsw = (unsigned)wid * 1024u;
    const int aoff = lds_byte(wr * 64 + fr, fq * 8), boff = lds_byte(wc * 32 + fr, fq * 8);
#define PG8_SA(b, h) (((b) * 2 + (h)) * HTB)
#define PG8_SB(b, h) ((4 + (b) * 2 + (h)) * HTB)
#define PG8_STAGE(bufoff, gbase, voff) do { _Pragma("unroll") for (int _i = 0; _i < 2; ++_i) \
        __builtin_amdgcn_global_load_lds((const unsigned*)((const char*)(gbase) + (voff)[_i]), (PG8_LAS unsigned*)(lds + (bufoff) + ldsw + _i * 8192), 16, 0, 0); } while (0)
#define PG8_LDA(dst, b, h) do { _Pragma("unroll") for (int m = 0; m < 4; ++m) _Pragma("unroll") for (int k = 0; k < 2; ++k) dst[m][k] = *(const PG8_LAS bf16x8*)(lds + PG8_SA(b, h) + aoff + m * 2048 + k * 1024); } while (0)
#define PG8_LDB(dst, b, h) do { _Pragma("unroll") for (int n = 0; n < 2; ++n) _Pragma("unroll") for (int k = 0; k < 2; ++k) dst[n][k] = *(const PG8_LAS bf16x8*)(lds + PG8_SB(b, h) + boff + n * 2048 + k * 1024); } while (0)
#define PG8_MMA(ai, bj, At, Bt) do { __builtin_amdgcn_s_setprio(1); _Pragma("unroll") for (int m = 0; m < 4; ++m) _Pragma("unroll") for (int n = 0; n < 2; ++n) _Pragma("unroll") for (int k = 0; k < 2; ++k) \
        acc[ai][bj][m][n] = __builtin_amdgcn_mfma_f32_16x16x32_bf16(Bt[n][k], At[m][k], acc[ai][bj][m][n], 0, 0, 0); __builtin_amdgcn_s_setprio(0); } while (0)
#define PG8_WAIT_V(n) asm volatile("s_waitcnt vmcnt(" #n ")" ::: "memory")
#define PG8_WAIT_L(n) asm volatile("s_waitcnt lgkmcnt(" #n ")" ::: "memory")
#define PG8_BAR __builtin_amdgcn_s_barrier()
#define PG8_SCHED __builtin_amdgcn_sched_barrier(0)
    Unit cur, nxt; int ui = 0;
    if (!S.next(0, cur)) return;
    f32x4 acc[2][2][4][2];
#pragma unroll
    for (int a = 0; a < 2; ++a)
#pragma unroll
        for (int b = 0; b < 2; ++b)
#pragma unroll
            for (int m = 0; m < 4; ++m)
#pragma unroll
                for (int n = 0; n < 2; ++n) acc[a][b][m][n] = (f32x4){0.f, 0.f, 0.f, 0.f};
    bf16x8 At[4][2], B0[2][2], B1[2][2];
    const char* cA = (const char*)g.A + (size_t)cur.pm * tstep; const char* cB = (const char*)g.Bt + (size_t)cur.pn * tstep;
    S.a_ready(cur);
    if constexpr (SP2) {
        PG8_STAGE(PG8_SB(0, 0), cB, voffB); PG8_STAGE(PG8_SB(0, 1), cB + hstep, voffB); PG8_STAGE(PG8_SA(0, 0), cA, voffA); PG8_STAGE(PG8_SA(0, 1), cA + hstep, voffA);
        if (wr == 1) PG8_BAR;
        PG8_WAIT_V(2); PG8_BAR;
        PG8_STAGE(PG8_SB(1, 0), cB + kstep, voffB); PG8_STAGE(PG8_SA(1, 0), cA + kstep, voffA); PG8_STAGE(PG8_SB(1, 1), cB + hstep + kstep, voffB);
        PG8_WAIT_V(6); PG8_BAR;
    } else {
        PG8_STAGE(PG8_SB(0, 0), cB, voffB); PG8_STAGE(PG8_SA(0, 0), cA, voffA); PG8_STAGE(PG8_SB(0, 1), cB + hstep, voffB); PG8_STAGE(PG8_SA(0, 1), cA + hstep, voffA);
        if (wr == 1) PG8_BAR;
        PG8_WAIT_V(4); PG8_BAR;
        PG8_STAGE(PG8_SB(1, 0), cB + kstep, voffB); PG8_STAGE(PG8_SA(1, 0), cA + kstep, voffA); PG8_STAGE(PG8_SB(1, 1), cB + hstep + kstep, voffB);
        PG8_WAIT_V(6); PG8_BAR;
    }
    for (;;) {
        const bool has_next = S.next(ui + 1, nxt);
        const char* nA = has_next ? (const char*)g.A + (size_t)nxt.pm * tstep : cA; const char* nB = has_next ? (const char*)g.Bt + (size_t)nxt.pn * tstep : cB;
        for (int t = 0; t < nt; t += 2) {
            const bool last = (t == nt - 2);
            const char* a1 = cA + (size_t)(t + 1) * kstep;
            const char* a2 = last ? nA : cA + (size_t)(t + 2) * kstep; const char* b2 = last ? nB : cB + (size_t)(t + 2) * kstep;
            const char* a3 = a2 + kstep; const char* b3 = b2 + kstep;
            if (last && has_next) S.a_ready(nxt);
            if constexpr (SP2) {
            PG8_LDB(B0, 0, 0); PG8_LDB(B1, 0, 1); PG8_SCHED; PG8_LDA(At, 0, 0); PG8_STAGE(PG8_SA(1, 1), a1 + hstep, voffA);
            PG8_WAIT_V(8); PG8_WAIT_L(0); PG8_BAR; PG8_MMA(0, 0, At, B0); PG8_MMA(0, 1, At, B1); PG8_BAR; PG8_SCHED;
            PG8_LDA(At, 0, 1); PG8_STAGE(PG8_SB(0, 0), b2, voffB); PG8_STAGE(PG8_SB(0, 1), b2 + hstep, voffB); PG8_STAGE(PG8_SA(0, 0), a2, voffA);
            PG8_WAIT_V(8); PG8_WAIT_L(0); PG8_BAR; PG8_MMA(1, 0, At, B0); PG8_MMA(1, 1, At, B1); PG8_BAR; PG8_SCHED;
            PG8_LDB(B0, 1, 0); PG8_LDB(B1, 1, 1); PG8_SCHED; PG8_LDA(At, 1, 0); PG8_STAGE(PG8_SA(0, 1), a2 + hstep, voffA);
            PG8_WAIT_V(8); PG8_WAIT_L(0); PG8_BAR; PG8_MMA(0, 0, At, B0); PG8_MMA(0, 1, At, B1); PG8_BAR; PG8_SCHED;
            PG8_LDA(At, 1, 1); PG8_STAGE(PG8_SB(1, 0), b3, voffB); PG8_STAGE(PG8_SB(1, 1), b3 + hstep, voffB); PG8_STAGE(PG8_SA(1, 0), a3, voffA);
            PG8_WAIT_V(8); PG8_WAIT_L(0); PG8_BAR; PG8_MMA(1, 0, At, B0); PG8_MMA(1, 1, At, B1); PG8_BAR; PG8_SCHED;
            } else {
            PG8_LDB(B0, 0, 0); PG8_SCHED; PG8_LDA(At, 0, 0); PG8_STAGE(PG8_SA(1, 1), a1 + hstep, voffA);
            PG8_WAIT_L(8); PG8_BAR; PG8_WAIT_L(0); PG8_MMA(0, 0, At, B0); PG8_BAR; PG8_SCHED;
            PG8_LDB(B1, 0, 1); PG8_STAGE(PG8_SB(0, 0), b2, voffB);
            PG8_BAR; PG8_WAIT_L(0); PG8_MMA(0, 1, At, B1); PG8_BAR;
            PG8_LDA(At, 0, 1); PG8_STAGE(PG8_SA(0, 0), a2, voffA);
            PG8_BAR; PG8_WAIT_L(0); PG8_MMA(1, 0, At, B0); PG8_BAR; PG8_SCHED;
            PG8_STAGE(PG8_SB(0, 1), b2 + hstep, voffB);
            PG8_WAIT_V(6); PG8_BAR; PG8_MMA(1, 1, At, B1); PG8_BAR;
            PG8_LDB(B0, 1, 0); PG8_SCHED; PG8_LDA(At, 1, 0); PG8_STAGE(PG8_SA(0, 1), a2 + hstep, voffA);
            PG8_WAIT_L(8); PG8_BAR; PG8_WAIT_L(0); PG8_MMA(0, 0, At, B0); PG8_BAR; PG8_SCHED;
            PG8_LDB(B1, 1, 1); PG8_STAGE(PG8_SB(1, 0), b3, voffB);
            PG8_BAR; PG8_WAIT_L(0); PG8_MMA(0, 1, At, B1); PG8_BAR;
            PG8_LDA(At, 1, 1); PG8_STAGE(PG8_SA(1, 0), a3, voffA);
            PG8_BAR; PG8_WAIT_L(0); PG8_MMA(1, 0, At, B0); PG8_BAR; PG8_SCHED;
            PG8_STAGE(PG8_SB(1, 1), b3 + hstep, voffB);
            PG8_WAIT_V(6); PG8_BAR; PG8_MMA(1, 1, At, B1); PG8_BAR;
            }
        }
        if constexpr (ALIGN_EPI) { if (wr == 0) PG8_BAR; }
        if constexpr (!Epi::AFTER_DRAIN) { E(acc, cur, wr, wc, fr, fq); S.done(cur); }
        if (!has_next) break;
#pragma unroll
        for (int a = 0; a < 2; ++a)
#pragma unroll
            for (int b = 0; b < 2; ++b)
#pragma unroll
                for (int m = 0; m < 4; ++m)
#pragma unroll
                    for (int n = 0; n < 2; ++n) acc[a][b][m][n] = (f32x4){0.f, 0.f, 0.f, 0.f};
        cur = nxt; cA = nA; cB = nB; ++ui;
        if constexpr (ALIGN_EPI) { if (wr == 1) PG8_BAR; }
    }
    PG8_WAIT_V(0);
    if constexpr (!ALIGN_EPI) { if (wr == 0) PG8_BAR; }
    PG8_BAR;
    if constexpr (Epi::AFTER_DRAIN) { E.fused(acc, cur, wr, wc, fr, fq, lds, wid, lane); S.done(cur); }
#undef PG8_SA
#undef PG8_SB
#undef PG8_STAGE
#undef PG8_LDA
#undef PG8_LDB
#undef PG8_MMA
#undef PG8_WAIT_V
#undef PG8_WAIT_L
#undef PG8_BAR
#undef PG8_SCHED
}
}

constexpr int NWAVES = 8;
constexpr int D = 1024, NB = 4, S = 4096, M = NB * S, FF = 3584, NE = 8, NH = 16;
constexpr int NMOD = 6 * D;
constexpr float C2 = 0.125f * 1.4426950408889634f;
constexpr float LOG2E = 1.4426950408889634f;
constexpr float RMS_EPS = 1e-6f;
constexpr int ECAP = 16384;

constexpr size_t MiB = 1u << 20;
constexpr size_t WS_CTL = 0, CTL_ZERO_BYTES = 1 * MiB;
constexpr size_t WS_MOD = 1 * MiB;
constexpr size_t WS_WFT = 1 * MiB + 512 * 1024;
constexpr size_t WS_LIST = 2 * MiB, WS_WL = 2 * MiB + 512 * 1024;
constexpr size_t WS_LOGFT = 3 * MiB;
constexpr size_t WS_WFOXIN = 4 * MiB, WS_WFOXOUT = 10 * MiB, WS_WSWAIN = 12 * MiB, WS_WSWAOUT = 15 * MiB, WS_WGU = 17 * MiB, WS_WDN = 31 * MiB;
constexpr size_t WS_WMGU = 38 * MiB, WS_WMDN = 150 * MiB;
constexpr size_t WS_XA = 206 * MiB;
constexpr size_t WS_YS = 270 * MiB;
constexpr size_t WS_XN = 334 * MiB;
constexpr size_t WS_QO = 366 * MiB, WS_K = 398 * MiB, WS_V = 430 * MiB;
constexpr size_t WS_ACT = 462 * MiB;
constexpr size_t WS_XS = 334 * MiB;
constexpr size_t WS_ACT2 = 590 * MiB;
constexpr size_t WS_END = 828 * MiB;
constexpr int CW_TMO = 0, CW_CODE = 1, CW_BAR = 4096, CW_CNT = 16384;
constexpr int RING_OFF = 0, RING_BYTES = 131072;
constexpr int LDSCTL_OFF = RING_BYTES, MISC_OFF = LDSCTL_OFF + 320;
constexpr int TAB_OFF = MISC_OFF + 128;
constexpr int RT_OFF = TAB_OFF + 128;
constexpr int LDS_BYTES = 147456;
static_assert(RT_OFF + 128 <= LDS_BYTES, "LDS map");

#define GAS __attribute__((address_space(1)))
#define LAS __attribute__((address_space(3)))
typedef unsigned short bf16;
typedef unsigned v4u __attribute__((ext_vector_type(4)));
typedef float f32x4 __attribute__((ext_vector_type(4)));
typedef short bf16x8 __attribute__((ext_vector_type(8)));
typedef GAS unsigned gu32;
typedef GAS unsigned long long gu64;
#define RLX_AGENT __ATOMIC_RELAXED, __HIP_MEMORY_SCOPE_AGENT
#define LDS_WAIT() asm volatile("s_waitcnt lgkmcnt(0)" ::: "memory")
#define VM_WAIT() asm volatile("s_waitcnt vmcnt(0)" ::: "memory")
__device__ __forceinline__ unsigned long long rt() { return __builtin_amdgcn_s_memrealtime(); }
__device__ __forceinline__ unsigned f2bf(float f) { unsigned u = __builtin_bit_cast(unsigned, f); return (u + 0x7fffu + ((u >> 16) & 1u)) >> 16; }
__device__ __forceinline__ unsigned pk2(float lo, float hi) { return f2bf(lo) | (f2bf(hi) << 16); }
#define XB_TMO      128
#define XB_XCNT(j)  (256  + 64 * (j))
#define XB_XSUB(j)  (1280 + 64 * (j))
#define XB_XGEN(j)  (2304 + 64 * (j))
#define XB_TOP      3328
#define XB_TOPGEN   3392
#define XCD_BAR_WORDS 3456
#define XB_SPIN_CAP (1u << 18)

__device__ __forceinline__ unsigned xb_ld(unsigned* p)              { return __hip_atomic_load(p, __ATOMIC_RELAXED, __HIP_MEMORY_SCOPE_AGENT); }
__device__ __forceinline__ unsigned xb_add(unsigned* p, unsigned v) { return __hip_atomic_fetch_add(p, v, __ATOMIC_RELAXED, __HIP_MEMORY_SCOPE_AGENT); }
__device__ __forceinline__ unsigned xb_xcc_id() { return (unsigned)__builtin_amdgcn_s_getreg((3 << 11) | 20) & 0xFu; }
#define XB_SPIN(cond, bar) do { unsigned _sp = 0; while (cond) { __builtin_amdgcn_s_sleep(1); \
    if ((++_sp & 255u) == 0u) { if (xb_ld(&(bar)[XB_TMO])) break; if (_sp > XB_SPIN_CAP) { atomicAdd(&(bar)[XB_TMO], 1u); break; } } } } while (0)

struct XcdBarrier {
    unsigned* bar; unsigned x;
    volatile LAS unsigned* st;
};

__device__ __forceinline__ XcdBarrier xcd_barrier_post(unsigned* bar, volatile LAS unsigned* st, const bool xb_leader) {
    XcdBarrier b; b.bar = bar; b.x = xb_xcc_id(); b.st = st;
    if (xb_leader) (void)xb_add(&bar[XB_XCNT(b.x)], 1u);
    return b;
}
__device__ __forceinline__ void xcd_barrier_complete(unsigned* bar, unsigned x, unsigned& nloc, unsigned& nx) {
    const unsigned G = gridDim.x * gridDim.y * gridDim.z;
    unsigned sum, cnt, mine, sp = 0u;
    for (;;) {
        sum = 0u; cnt = 0u; mine = 0u;
#pragma unroll
        for (unsigned j = 0; j < 16; ++j) { const unsigned c = xb_ld(&bar[XB_XCNT(j)]); sum += c; cnt += (c > 0u) ? 1u : 0u; mine = (j == x) ? c : mine; }
        if (sum == G) break;
        __builtin_amdgcn_s_sleep(1);
        if ((++sp & 255u) == 0u) { if (xb_ld(&bar[XB_TMO])) break; if (sp > XB_SPIN_CAP) { atomicAdd(&bar[XB_TMO], 1u); break; } }
    }
    nloc = mine > 0u ? mine : 1u; nx = cnt > 0u ? cnt : 1u;
}

__device__ __forceinline__ void xcd_barrier(const XcdBarrier& b, const bool xb_leader) {
    asm volatile("s_waitcnt vmcnt(0)" ::: "memory");
    __syncthreads();
    if (xb_leader) {
        unsigned* bar = b.bar;
        __builtin_amdgcn_s_waitcnt(0);
        unsigned nloc = b.st[0], nx = b.st[1];
        if (nloc == 0u) { xcd_barrier_complete(bar, b.x, nloc, nx); b.st[0] = nloc; b.st[1] = nx; }
        const unsigned old = xb_add(&bar[XB_XSUB(b.x)], 1u);
        const unsigned gen = old / nloc;
        if (old + 1u == (gen + 1u) * nloc) {
            __builtin_amdgcn_fence(__ATOMIC_RELEASE, "agent");
            asm volatile("s_waitcnt vmcnt(0)" ::: "memory");
            const unsigned og = xb_add(&bar[XB_TOP], 1u);
            const unsigned tg = og / nx;
            if (og + 1u == (tg + 1u) * nx) xb_add(&bar[XB_TOPGEN], 1u);
            else XB_SPIN(xb_ld(&bar[XB_TOPGEN]) == tg, bar);
            __builtin_amdgcn_fence(__ATOMIC_ACQUIRE, "agent");
            xb_add(&bar[XB_XGEN(b.x)], 1u);
            asm volatile("s_waitcnt vmcnt(0)" ::: "memory");
        } else {
            XB_SPIN(xb_ld(&bar[XB_XGEN(b.x)]) == gen, bar);
            __builtin_amdgcn_fence(__ATOMIC_ACQUIRE, "agent");
            asm volatile("s_waitcnt vmcnt(0)" ::: "memory");
        }
    }
    __syncthreads();
}

struct Frame {
    LAS unsigned char* lds;
    volatile LAS unsigned* MISC;
    gu32* ctl;
    unsigned char* ws;
    int wave;
    int vcu, G;
};
struct Args { const float* in[20]; float* out; unsigned char* ws; int ph_lo, ph_hi; };

__device__ __forceinline__ float wave_sum(float v) {
#pragma unroll
    for (int o = 1; o < 64; o <<= 1) v += __shfl_xor(v, o);
    return v;
}
__device__ __forceinline__ float bf_lo(unsigned w) { return __uint_as_float(w << 16); }
__device__ __forceinline__ float bf_hi(unsigned w) { return __uint_as_float(w & 0xffff0000u); }

__device__ __forceinline__ void tr_item(const float* W, int ld, int K, int nblk, int item, bf16* WT, bool gu, LAS float* scr, int lane) {
    const int kb = item / nblk, nb = item % nblk, k0 = 64 * kb, n0 = 32 * nb;
    int drow0 = n0;
    if (gu) { const int bj = n0 / FF, j = n0 - bj * FF; drow0 = 256 * (j / 128) + 128 * bj + (j % 128); }
#pragma unroll 8
    for (int i = 0; i < 32; ++i) { const int kk = 2 * i + (lane >> 5); scr[kk * 33 + (lane & 31)] = W[(size_t)(k0 + kk) * ld + n0 + (lane & 31)]; }
    LDS_WAIT(); asm volatile("" ::: "memory");
    const int c = lane & 7;
#pragma unroll
    for (int j = 0; j < 4; ++j) { const int n = (lane >> 3) + 8 * j; const LAS float* s = scr + (8 * c) * 33 + n;
        v4u o; o.x = pk2(s[0 * 33], s[1 * 33]); o.y = pk2(s[2 * 33], s[3 * 33]); o.z = pk2(s[4 * 33], s[5 * 33]); o.w = pk2(s[6 * 33], s[7 * 33]);
        *(GAS v4u*)(WT + (size_t)(drow0 + n) * K + k0 + 8 * c) = o; }
    LDS_WAIT(); asm volatile("" ::: "memory");
}
__device__ __forceinline__ void p0_prologue(Frame& F, const Args& a) {
    const int lane = pg8::pg8_lane_id(), tid = F.wave * 64 + lane; (void)tid;
    const float* c_in = a.in[1]; const float* w_ada = a.in[2]; const float* b_ada = a.in[3];
    float* MOD = (float*)(F.ws + WS_MOD);
    LAS float* sc = (LAS float*)(F.lds + RING_OFF + 96 * 1024);
    LAS float* red = (LAS float*)(F.lds + RING_OFF + 112 * 1024);
    for (int i = tid; i < NB * D; i += NWAVES * 64) { const float v = c_in[i]; sc[i] = v / (1.f + __expf(-v)); }
    __syncthreads();
    for (int item = blockIdx.x; item < 2 * (NMOD / 32); item += F.G) {
        const int l = item / (NMOD / 32), n0 = (item % (NMOD / 32)) * 32, col = lane & 31, kpar = lane >> 5;
        const float* wp = w_ada + (size_t)l * D * NMOD + n0 + col;
        float a0 = 0.f, a1 = 0.f, a2 = 0.f, a3 = 0.f;
#pragma unroll 8
        for (int i = 0; i < 64; ++i) { const int k = 128 * F.wave + 2 * i + kpar; const float wv = wp[(size_t)k * NMOD];
            a0 += sc[k] * wv; a1 += sc[D + k] * wv; a2 += sc[2 * D + k] * wv; a3 += sc[3 * D + k] * wv; }
        a0 += __shfl_xor(a0, 32); a1 += __shfl_xor(a1, 32); a2 += __shfl_xor(a2, 32); a3 += __shfl_xor(a3, 32);
        if (lane < 32) { red[(F.wave * 4 + 0) * 32 + col] = a0; red[(F.wave * 4 + 1) * 32 + col] = a1; red[(F.wave * 4 + 2) * 32 + col] = a2; red[(F.wave * 4 + 3) * 32 + col] = a3; }
        __syncthreads();
        if (tid < 128) { const int b = tid >> 5, cc = tid & 31; float s = 0.f;
#pragma unroll
            for (int w = 0; w < 8; ++w) s += red[(w * 4 + b) * 32 + cc];
            MOD[(size_t)(l * NB + b) * NMOD + n0 + cc] = s + b_ada[l * NMOD + n0 + cc]; }
        __syncthreads();
    }
    { bf16* WFT = (bf16*)(F.ws + WS_WFT); const float* w = a.in[7];
      for (int i = blockIdx.x * (NWAVES * 64) + tid; i < 16 * D; i += F.G * NWAVES * 64) { const int hh = i & 15, k = i >> 4; WFT[hh * D + k] = (bf16)f2bf(w[(size_t)k * (3 * D + 16) + 3 * D + hh]); } }
    LAS float* scr = (LAS float*)(F.lds + RING_OFF + F.wave * 8448);
    const int gw = F.vcu * NWAVES + F.wave, NGW = F.G * NWAVES;
    constexpr int I_FI = 16 * 96, I_FO = 16 * 32, I_SI = 16 * 48, I_SO = 16 * 32, I_GU = 16 * 224, I_DN = 56 * 32;
    constexpr int NITEMS = I_FI + I_FO + I_SI + I_SO + I_GU + I_DN + NE * (I_GU + I_DN);
    for (int it = gw; it < NITEMS; it += NGW) {
        int r = it;
        if (r < I_FI) { tr_item(a.in[7], 3 * D + 16, D, 96, r, (bf16*)(F.ws + WS_WFOXIN), false, scr, lane); continue; } r -= I_FI;
        if (r < I_FO) { tr_item(a.in[9], D, D, 32, r, (bf16*)(F.ws + WS_WFOXOUT), false, scr, lane); continue; } r -= I_FO;
        if (r < I_SI) { tr_item(a.in[10], D + 512, D, 48, r, (bf16*)(F.ws + WS_WSWAIN), false, scr, lane); continue; } r -= I_SI;
        if (r < I_SO) { tr_item(a.in[12], D, D, 32, r, (bf16*)(F.ws + WS_WSWAOUT), false, scr, lane); continue; } r -= I_SO;
        if (r < I_GU) { tr_item(a.in[14], 2 * FF, D, 224, r, (bf16*)(F.ws + WS_WGU), true, scr, lane); continue; } r -= I_GU;
        if (r < I_DN) { tr_item(a.in[15], D, FF, 32, r, (bf16*)(F.ws + WS_WDN), false, scr, lane); continue; } r -= I_DN;
        if (r < NE * I_GU) { const int e = r / I_GU, rr = r % I_GU; tr_item(a.in[18] + (size_t)e * D * 2 * FF, 2 * FF, D, 224, rr, (bf16*)(F.ws + WS_WMGU) + (size_t)e * 2 * FF * D, true, scr, lane); continue; } r -= NE * I_GU;
        { const int e = r / I_DN, rr = r % I_DN; tr_item(a.in[19] + (size_t)e * FF * D, D, FF, 32, rr, (bf16*)(F.ws + WS_WMDN) + (size_t)e * D * FF, false, scr, lane); }
    }
}

__device__ __forceinline__ void norm_mod_rows(Frame& F, const float* xin, const float* g, const float* shift, const float* scale, bf16* XN) {
    const int lane = pg8::pg8_lane_id(), tid = F.wave * 64 + lane; (void)tid;
    const int gw = F.vcu * NWAVES + F.wave, NGW = F.G * NWAVES;
    for (int rg = gw; rg < M / 8; rg += NGW) {
        const int row0 = rg * 8, b = row0 / S;
        f32x4 gs[4], sh[4];
#pragma unroll
        for (int j = 0; j < 4; ++j) { const f32x4 gv = ((const GAS f32x4*)g)[lane + 64 * j], sv = ((const GAS f32x4*)(scale + (size_t)b * NMOD))[lane + 64 * j];
            gs[j] = gv * (sv + 1.0f); sh[j] = ((const GAS f32x4*)(shift + (size_t)b * NMOD))[lane + 64 * j]; }
#pragma unroll 2
        for (int r = 0; r < 8; ++r) {
            const GAS f32x4* xr = (const GAS f32x4*)(xin + (size_t)(row0 + r) * D) + lane;
            f32x4 v[4]; float s = 0.f;
#pragma unroll
            for (int j = 0; j < 4; ++j) { v[j] = xr[64 * j]; s += (v[j].x * v[j].x + v[j].y * v[j].y) + (v[j].z * v[j].z + v[j].w * v[j].w); }
            const float rstd = rsqrtf(wave_sum(s) * (1.f / D) + RMS_EPS);
            GAS unsigned long long* o8 = (GAS unsigned long long*)(XN + (size_t)(row0 + r) * D) + lane;
#pragma unroll
            for (int j = 0; j < 4; ++j) { const f32x4 y = v[j] * rstd * gs[j] + sh[j];
                o8[64 * j] = (unsigned long long)pg8::cvt_pk_bf16(y.x, y.y) | ((unsigned long long)pg8::cvt_pk_bf16(y.z, y.w) << 32); }
        }
    }
}
__device__ __forceinline__ void fgate_groups(Frame& F, const bf16* XN, const bf16* WFT, const float* b_f, float* LOGFT) {
    const int lane = pg8::pg8_lane_id(), tid = F.wave * 64 + lane; (void)tid;
    const int gw = F.vcu * NWAVES + F.wave, NGW = F.G * NWAVES, fr = lane & 15, fq = lane >> 4;
    for (int grp = gw; grp < M / 16; grp += NGW) {
        const int row0 = grp * 16;
        const bf16* ap = XN + (size_t)(row0 + fr) * D + 8 * fq; const bf16* wp = WFT + (size_t)fr * D + 8 * fq;
        f32x4 acc = (f32x4){0.f, 0.f, 0.f, 0.f};
#pragma unroll 8
        for (int kk = 0; kk < 32; ++kk) { const bf16x8 xv = *(const GAS bf16x8*)(ap + 32 * kk), wv = *(const GAS bf16x8*)(wp + 32 * kk);
            acc = __builtin_amdgcn_mfma_f32_16x16x32_bf16(wv, xv, acc, 0, 0, 0); }
        const int row = row0 + fr, b = row / S, s = row % S;
#pragma unroll
        for (int r = 0; r < 4; ++r) { const int hh = 4 * fq + r; const float z = acc[r] + b_f[hh];
            const float ls = fminf(z, 0.f) - log1pf(__expf(-fabsf(z)));
            LOGFT[(size_t)(b * NH + hh) * S + s] = ls * LOG2E; }
    }
}
__device__ __forceinline__ void block_scan4096(Frame& F, const float* src, LAS float* cum, LAS float* part) {
    const int lane = pg8::pg8_lane_id(), tid = F.wave * 64 + lane; (void)tid;
    const GAS f32x4* p = (const GAS f32x4*)src + 2 * tid;
    const f32x4 a = p[0], b = p[1];
    float v[8]; v[0] = a.x; v[1] = v[0] + a.y; v[2] = v[1] + a.z; v[3] = v[2] + a.w; v[4] = v[3] + b.x; v[5] = v[4] + b.y; v[6] = v[5] + b.z; v[7] = v[6] + b.w;
    float incl = v[7];
#pragma unroll
    for (int o = 1; o < 64; o <<= 1) { const float t = __shfl_up(incl, o); if (lane >= o) incl += t; }
    if (lane == 63) part[F.wave] = incl;
    __syncthreads();
    float base = incl - v[7];
#pragma unroll
    for (int w = 0; w < 8; ++w) if (w < F.wave) base += part[w];
#pragma unroll
    for (int i = 0; i < 8; ++i) cum[8 * tid + i] = v[i] + base;
    __syncthreads();
}
__device__ __forceinline__ void simple_attn_row_init(const bf16* qrow, unsigned (&q2)[32]) {
#pragma unroll
    for (int i = 0; i < 8; ++i) { const v4u t = *(const GAS v4u*)(qrow + 8 * i); q2[4 * i] = t.x; q2[4 * i + 1] = t.y; q2[4 * i + 2] = t.z; q2[4 * i + 3] = t.w; }
}
__device__ __forceinline__ void simple_kv_tile_load(const bf16* kbase, const bf16* vbase, size_t pitch, LAS unsigned char* reg, int lane) {
    const int key = lane >> 1, half = lane & 1;
#pragma unroll
    for (int i = 0; i < 4; ++i) { *(LAS v4u*)(reg + key * 128 + half * 64 + 16 * i) = *(const GAS v4u*)(kbase + (size_t)key * pitch + half * 32 + 8 * i);
        *(LAS v4u*)(reg + 4096 + key * 128 + half * 64 + 16 * i) = *(const GAS v4u*)(vbase + (size_t)key * pitch + half * 32 + 8 * i); }
    LDS_WAIT(); __builtin_amdgcn_wave_barrier(); asm volatile("" ::: "memory");
}
__device__ __forceinline__ float simple_dot(const unsigned (&q2)[32], const LAS unsigned char* krow) {
    float s = 0.f;
#pragma unroll
    for (int i = 0; i < 8; ++i) { const v4u t = *(const LAS v4u*)(krow + 16 * i);
        s += bf_lo(q2[4 * i]) * bf_lo(t.x) + bf_hi(q2[4 * i]) * bf_hi(t.x); s += bf_lo(q2[4 * i + 1]) * bf_lo(t.y) + bf_hi(q2[4 * i + 1]) * bf_hi(t.y);
        s += bf_lo(q2[4 * i + 2]) * bf_lo(t.z) + bf_hi(q2[4 * i + 2]) * bf_hi(t.z); s += bf_lo(q2[4 * i + 3]) * bf_lo(t.w) + bf_hi(q2[4 * i + 3]) * bf_hi(t.w); }
    return s;
}
__device__ __forceinline__ void simple_pv(float (&acc)[64], float al, float p, const LAS unsigned char* vrow) {
#pragma unroll
    for (int i = 0; i < 8; ++i) { const v4u t = *(const LAS v4u*)(vrow + 16 * i);
        acc[8 * i + 0] = acc[8 * i + 0] * al + p * bf_lo(t.x); acc[8 * i + 1] = acc[8 * i + 1] * al + p * bf_hi(t.x);
        acc[8 * i + 2] = acc[8 * i + 2] * al + p * bf_lo(t.y); acc[8 * i + 3] = acc[8 * i + 3] * al + p * bf_hi(t.y);
        acc[8 * i + 4] = acc[8 * i + 4] * al + p * bf_lo(t.z); acc[8 * i + 5] = acc[8 * i + 5] * al + p * bf_hi(t.z);
        acc[8 * i + 6] = acc[8 * i + 6] * al + p * bf_lo(t.w); acc[8 * i + 7] = acc[8 * i + 7] * al + p * bf_hi(t.w); }
}
__device__ __forceinline__ void simple_store_row(bf16* orow, const float (&acc)[64], float inv) {
#pragma unroll
    for (int i = 0; i < 8; ++i) { v4u t; t.x = pg8::cvt_pk_bf16(acc[8 * i] * inv, acc[8 * i + 1] * inv); t.y = pg8::cvt_pk_bf16(acc[8 * i + 2] * inv, acc[8 * i + 3] * inv);
        t.z = pg8::cvt_pk_bf16(acc[8 * i + 4] * inv, acc[8 * i + 5] * inv); t.w = pg8::cvt_pk_bf16(acc[8 * i + 6] * inv, acc[8 * i + 7] * inv); *(GAS v4u*)(orow + 8 * i) = t; }
}
__device__ __forceinline__ void fox_attn_simple(Frame& F, const bf16* Q, const bf16* K, const bf16* V, bf16* O, const float* LOGFT) {
    const int lane = pg8::pg8_lane_id(), tid = F.wave * 64 + lane; (void)tid;
    LAS float* cum = (LAS float*)(F.lds + RING_OFF + 65536); LAS float* part = (LAS float*)(F.lds + RING_OFF + 65536 + 16384);
    LAS unsigned char* reg = F.lds + RING_OFF + F.wave * 8192;
    for (int pb = F.vcu; pb < 256; pb += F.G) {
        const int bh = pb >> 2, b = bh / NH, h = bh % NH;
        block_scan4096(F, LOGFT + (size_t)bh * S, cum, part);
        const int j = (pb * 8 + F.wave) & 31;
        for (int which = 0; which < 2; ++which) {
            const int qt = which ? 63 - j : j, row = qt * 64 + lane;
            unsigned q2[32]; simple_attn_row_init(Q + (size_t)(b * S + row) * D + h * 64, q2);
            float acc[64];
#pragma unroll
            for (int d = 0; d < 64; ++d) acc[d] = 0.f;
            float m = -INFINITY, l = 0.f; const float cq = cum[row];
            for (int kt = 0; kt < 2 * qt + 2; ++kt) {
                __builtin_amdgcn_wave_barrier(); asm volatile("" ::: "memory");
                simple_kv_tile_load(K + (size_t)(b * S + kt * 32) * D + h * 64, V + (size_t)(b * S + kt * 32) * D + h * 64, D, reg, lane);
                for (int jj = 0; jj < 32; ++jj) { const int key = kt * 32 + jj;
                    const float s = simple_dot(q2, reg + jj * 128) + cq - cum[key];
                    if (key <= row) { const float mn = fmaxf(m, s), al = __builtin_amdgcn_exp2f(m - mn), p = __builtin_amdgcn_exp2f(s - mn); l = l * al + p; m = mn; simple_pv(acc, al, p, reg + 4096 + jj * 128); } }
            }
            simple_store_row(O + (size_t)(b * S + row) * D + h * 64, acc, 1.f / l);
        }
        __syncthreads();
    }
}
__device__ __forceinline__ int t5_bucket(int rel) {
    const int n = rel < 0 ? -rel : rel;
    const int v = n < 8 ? n : 8 + (n >= 12) + (n >= 16) + (n >= 23) + (n >= 32) + (n >= 46) + (n >= 64) + (n >= 91);
    return (rel > 0 ? 16 : 0) + v;
}
__device__ __forceinline__ void swa_attn_simple(Frame& F, const bf16* Q, const bf16* K, const bf16* V, bf16* O, const float* sinks, const float* rel_bias) {
    const int lane = pg8::pg8_lane_id(), tid = F.wave * 64 + lane; (void)tid;
    LAS unsigned char* reg = F.lds + RING_OFF + F.wave * 8192;
    LAS float* T = (LAS float*)(F.lds + RING_OFF + 65536 + F.wave * 1024);
    const int gw = F.vcu * NWAVES + F.wave, NGW = F.G * NWAVES;
    for (int ui = gw; ui < NB * 64 * NH; ui += NGW) {
        const int hq = ui % NH, c = (ui / NH) % 64, b = ui / (NH * 64), hk = hq >> 2, row = c * 64 + lane;
        __builtin_amdgcn_wave_barrier(); asm volatile("" ::: "memory");
        for (int i = lane; i < 255; i += 64) T[i] = rel_bias[t5_bucket(i - 191) * NH + hq] * LOG2E;
        unsigned q2[32]; simple_attn_row_init(Q + (size_t)(b * S + row) * D + hq * 64, q2);
        float acc[64];
#pragma unroll
        for (int d = 0; d < 64; ++d) acc[d] = 0.f;
        float m = -INFINITY, l = 0.f;
        for (int kt = 0; kt < 6; ++kt) {
            const int pos0 = 64 * c - 128 + 32 * kt; if (pos0 < 0) continue;
            __builtin_amdgcn_wave_barrier(); asm volatile("" ::: "memory");
            simple_kv_tile_load(K + (size_t)(b * S + pos0) * 256 + hk * 64, V + (size_t)(b * S + pos0) * 256 + hk * 64, 256, reg, lane);
            for (int jj = 0; jj < 32; ++jj) { const int kb = 32 * kt + jj;
                const float s = simple_dot(q2, reg + jj * 128) + T[kb + 63 - lane];
                const float mn = fmaxf(m, s), al = __builtin_amdgcn_exp2f(m - mn), p = __builtin_amdgcn_exp2f(s - mn); l = l * al + p; m = mn; simple_pv(acc, al, p, reg + 4096 + jj * 128); }
        }
        const float sk = sinks[hq] * LOG2E, mf = fmaxf(m, sk), al = __builtin_amdgcn_exp2f(m - mf);
        l = l * al + __builtin_amdgcn_exp2f(sk - mf);
        simple_store_row(O + (size_t)(b * S + row) * D + hq * 64, acc, al / l);
    }
}
__device__ __forceinline__ void route_rows(Frame& F, const float* xin, const float* g, const float* shift, const float* scale, const float* w_router, const float* b_router,
                                           bf16* XS, int* list, float* wl, gu32* cnt) {
    const int lane = pg8::pg8_lane_id(), tid = F.wave * 64 + lane; (void)tid;
    LAS float* wr = (LAS float*)(F.lds + RING_OFF);
    volatile LAS int* rt = (volatile LAS int*)(F.lds + RT_OFF);
    for (int i = tid; i < D * NE; i += NWAVES * 64) wr[i] = w_router[i];
    for (int blk = F.vcu; blk < M / 32; blk += F.G) {
        if (tid < 16) rt[tid] = 0;
        __syncthreads();
        const int row0 = blk * 32 + F.wave * 4, b = row0 / S;
        f32x4 gs[4], sh[4];
#pragma unroll
        for (int j = 0; j < 4; ++j) { const f32x4 gv = ((const GAS f32x4*)g)[lane + 64 * j], sv = ((const GAS f32x4*)(scale + (size_t)b * NMOD))[lane + 64 * j];
            gs[j] = gv * (sv + 1.0f); sh[j] = ((const GAS f32x4*)(shift + (size_t)b * NMOD))[lane + 64 * j]; }
        unsigned hp[4][8]; int e0[4], e1[4], p0[4], p1[4]; float w0[4];
#pragma unroll
        for (int r = 0; r < 4; ++r) {
            const GAS f32x4* xr = (const GAS f32x4*)(xin + (size_t)(row0 + r) * D) + lane;
            f32x4 v[4]; float s = 0.f;
#pragma unroll
            for (int j = 0; j < 4; ++j) { v[j] = xr[64 * j]; s += (v[j].x * v[j].x + v[j].y * v[j].y) + (v[j].z * v[j].z + v[j].w * v[j].w); }
            const float rstd = rsqrtf(wave_sum(s) * (1.f / D) + RMS_EPS);
            float lg[8];
#pragma unroll
            for (int e = 0; e < 8; ++e) lg[e] = 0.f;
#pragma unroll
            for (int j = 0; j < 4; ++j) { const f32x4 y = v[j] * rstd * gs[j] + sh[j];
                hp[r][2 * j] = pg8::cvt_pk_bf16(y.x, y.y); hp[r][2 * j + 1] = pg8::cvt_pk_bf16(y.z, y.w);
#pragma unroll
                for (int i = 0; i < 4; ++i) { const LAS f32x4* wq = (const LAS f32x4*)(wr + (size_t)(4 * lane + 256 * j + i) * 8); const f32x4 wa = wq[0], wb = wq[1]; const float yv = y[i];
                    lg[0] += yv * wa.x; lg[1] += yv * wa.y; lg[2] += yv * wa.z; lg[3] += yv * wa.w; lg[4] += yv * wb.x; lg[5] += yv * wb.y; lg[6] += yv * wb.z; lg[7] += yv * wb.w; } }
#pragma unroll
            for (int e = 0; e < 8; ++e) lg[e] = wave_sum(lg[e]) + b_router[e];
            int i0 = 0; float v0 = lg[0];
#pragma unroll
            for (int e = 1; e < 8; ++e) if (lg[e] > v0) { v0 = lg[e]; i0 = e; }
            int i1 = 0; float v1 = -INFINITY;
#pragma unroll
            for (int e = 0; e < 8; ++e) if (e != i0 && lg[e] > v1) { v1 = lg[e]; i1 = e; }
            const float wt1 = 1.f / (1.f + __expf(v0 - v1));
            e0[r] = i0; e1[r] = i1; w0[r] = 1.f - wt1;
            int q0 = 0, q1 = 0;
            if (lane == 0) { q0 = __hip_atomic_fetch_add((LAS int*)rt + i0, 1, __ATOMIC_RELAXED, __HIP_MEMORY_SCOPE_WORKGROUP); q1 = __hip_atomic_fetch_add((LAS int*)rt + i1, 1, __ATOMIC_RELAXED, __HIP_MEMORY_SCOPE_WORKGROUP); }
            p0[r] = __builtin_amdgcn_readfirstlane(q0); p1[r] = __builtin_amdgcn_readfirstlane(q1);
        }
        __syncthreads();
        if (tid < 8) rt[8 + tid] = (int)__hip_atomic_fetch_add(cnt + 64 * tid, (unsigned)rt[tid], __ATOMIC_RELAXED, __HIP_MEMORY_SCOPE_AGENT);
        __syncthreads();
#pragma unroll
        for (int r = 0; r < 4; ++r) {
            const int tok = row0 + r;
            const int d0 = e0[r] * ECAP + rt[8 + e0[r]] + p0[r], d1 = e1[r] * ECAP + rt[8 + e1[r]] + p1[r];
            GAS unsigned long long* o0 = (GAS unsigned long long*)(XS + (size_t)d0 * D) + lane; GAS unsigned long long* o1 = (GAS unsigned long long*)(XS + (size_t)d1 * D) + lane;
#pragma unroll
            for (int j = 0; j < 4; ++j) { const unsigned long long pk = (unsigned long long)hp[r][2 * j] | ((unsigned long long)hp[r][2 * j + 1] << 32); o0[64 * j] = pk; o1[64 * j] = pk; }
            if (lane == 0) { list[d0] = 2 * tok; wl[d0] = w0[r]; list[d1] = 2 * tok + 1; wl[d1] = 1.f - w0[r]; }
        }
        __syncthreads();
    }
}
__device__ __forceinline__ void final_rows(Frame& F, const float* XA, const bf16* YS, const float* gate, const float* g, float* out) {
    const int lane = pg8::pg8_lane_id(), tid = F.wave * 64 + lane; (void)tid;
    const int gw = F.vcu * NWAVES + F.wave, NGW = F.G * NWAVES;
    for (int rg = gw; rg < M / 8; rg += NGW) {
        const int row0 = rg * 8, b = row0 / S;
        f32x4 gt[4], gf[4];
#pragma unroll
        for (int j = 0; j < 4; ++j) { gt[j] = ((const GAS f32x4*)(gate + (size_t)b * NMOD))[lane + 64 * j]; gf[j] = ((const GAS f32x4*)g)[lane + 64 * j]; }
#pragma unroll 2
        for (int r = 0; r < 8; ++r) {
            const int row = row0 + r;
            const GAS f32x4* xr = (const GAS f32x4*)(XA + (size_t)row * D) + lane;
            const GAS unsigned long long* y0 = (const GAS unsigned long long*)(YS + (size_t)(2 * row) * D) + lane; const GAS unsigned long long* y1 = (const GAS unsigned long long*)(YS + (size_t)(2 * row + 1) * D) + lane;
            f32x4 v[4]; float s = 0.f;
#pragma unroll
            for (int j = 0; j < 4; ++j) { const unsigned long long a = y0[64 * j], c = y1[64 * j]; const unsigned al = (unsigned)a, ah = (unsigned)(a >> 32), cl = (unsigned)c, ch = (unsigned)(c >> 32);
                const f32x4 ys = (f32x4){bf_lo(al) + bf_lo(cl), bf_hi(al) + bf_hi(cl), bf_lo(ah) + bf_lo(ch), bf_hi(ah) + bf_hi(ch)};
                v[j] = xr[64 * j] + gt[j] * ys; s += (v[j].x * v[j].x + v[j].y * v[j].y) + (v[j].z * v[j].z + v[j].w * v[j].w); }
            const float rstd = rsqrtf(wave_sum(s) * (1.f / D) + RMS_EPS);
            GAS f32x4* o = (GAS f32x4*)(out + (size_t)row * D) + lane;
#pragma unroll
            for (int j = 0; j < 4; ++j) o[64 * j] = v[j] * rstd * gf[j];
        }
    }
}

__global__ void __launch_bounds__(NWAVES * 64, 2) mk_fwd(Args args) {
    extern __shared__ __attribute__((aligned(16))) unsigned char lds[];
    Frame F;
    F.lds = (LAS unsigned char*)lds;
    F.MISC = (volatile LAS unsigned*)(F.lds + MISC_OFF);
    F.wave = __builtin_amdgcn_readfirstlane((int)threadIdx.x >> 6);
    F.G = gridDim.x; { const int bx = blockIdx.x; F.vcu = (F.G % 8 == 0) ? (bx % 8) * (F.G / 8) + bx / 8 : bx; }
    F.ws = args.ws; F.ctl = (gu32*)(args.ws + WS_CTL);
    for (int u = F.wave * 64 + pg8::pg8_lane_id(); u < (LDS_BYTES - LDSCTL_OFF) / 4; u += NWAVES * 64) ((LAS unsigned*)(F.lds + LDSCTL_OFF))[u] = 0u;
    __syncthreads();
    XcdBarrier bar = xcd_barrier_post((unsigned*)(F.ctl + CW_BAR), F.MISC + 8, F.wave == 0 && pg8::pg8_lane_id() == 0);
    const int lo = args.ph_lo, hi = args.ph_hi;
#define IN(k) (lo <= (k) && (k) < hi)
#define SEAM(k) do { if (IN(k) && IN((k) + 1)) xcd_barrier(bar, F.wave == 0 && pg8::pg8_lane_id() == 0); } while (0)
    unsigned char* ws = args.ws;
    const float* MOD0 = (const float*)(ws + WS_MOD); const float* MOD1 = MOD0 + NB * NMOD;
    bf16* XN = (bf16*)(ws + WS_XN); bf16* QO = (bf16*)(ws + WS_QO); bf16* KB = (bf16*)(ws + WS_K); bf16* VB = (bf16*)(ws + WS_V);
    float* XA = (float*)(ws + WS_XA); bf16* ACT = (bf16*)(ws + WS_ACT); bf16* XS = (bf16*)(ws + WS_XS); bf16* ACT2 = (bf16*)(ws + WS_ACT2); bf16* YS = (bf16*)(ws + WS_YS);
    float* LOGFT = (float*)(ws + WS_LOGFT);

    if (IN(0)) { p0_prologue(F, args); } SEAM(0);
    if (IN(1)) { norm_mod_rows(F, args.in[0], args.in[4], MOD0 + 0 * D, MOD0 + 1 * D, XN); } SEAM(1);
    if (IN(2)) {
        fgate_groups(F, XN, (const bf16*)(ws + WS_WFT), args.in[8], LOGFT);
        pg8::Gemm g{XN, (const pg8::bf16_t*)(ws + WS_WFOXIN), M, 3 * D, D}; pg8::StaticOrder So; So.init(M, 3 * D, F.G, (int)blockIdx.x);
        pg8::EpiQKV<0> E{QO, (size_t)(WS_K - WS_QO) / 2, C2};
        pg8::gemm_phase<pg8::EpiQKV<0>, pg8::StaticOrder, true, true>(F.lds + RING_OFF, g, So, E, F.wave);
    } SEAM(2);
    if (IN(3)) { fox_attn_simple(F, QO, KB, VB, QO, LOGFT); } SEAM(3);
    if (IN(4)) {
        pg8::Gemm g{QO, (const pg8::bf16_t*)(ws + WS_WFOXOUT), M, D, D}; pg8::StaticOrder So; So.init(M, D, F.G, (int)blockIdx.x);
        pg8::EpiResid E{args.in[0], XA, MOD0 + 2 * D, D, S, NMOD};
        pg8::gemm_phase<pg8::EpiResid, pg8::StaticOrder, true, true>(F.lds + RING_OFF, g, So, E, F.wave);
    } SEAM(4);
    if (IN(5)) { norm_mod_rows(F, XA, args.in[5], MOD0 + 3 * D, MOD0 + 4 * D, XN); } SEAM(5);
    if (IN(6)) {
        pg8::Gemm g{XN, (const pg8::bf16_t*)(ws + WS_WGU), M, 2 * FF, D}; pg8::StaticOrder So; So.init(M, 2 * FF, F.G, (int)blockIdx.x);
        pg8::EpiSwiglu E{ACT, FF};
        pg8::gemm_phase<pg8::EpiSwiglu, pg8::StaticOrder, true, true>(F.lds + RING_OFF, g, So, E, F.wave);
    } SEAM(6);
    if (IN(7)) {
        pg8::Gemm g{ACT, (const pg8::bf16_t*)(ws + WS_WDN), M, D, FF}; pg8::StaticOrder So; So.init(M, D, F.G, (int)blockIdx.x);
        pg8::EpiResid E{XA, XA, MOD0 + 5 * D, D, S, NMOD};
        pg8::gemm_phase<pg8::EpiResid, pg8::StaticOrder, true, true>(F.lds + RING_OFF, g, So, E, F.wave);
    } SEAM(7);
    if (IN(8)) { norm_mod_rows(F, XA, args.in[4] + D, MOD1 + 0 * D, MOD1 + 1 * D, XN); } SEAM(8);
    if (IN(9)) {
        pg8::Gemm g{XN, (const pg8::bf16_t*)(ws + WS_WSWAIN), M, D + 512, D}; pg8::StaticOrder So; So.init(M, D + 512, F.G, (int)blockIdx.x);
        pg8::EpiQKV<1> E{QO, (size_t)(WS_K - WS_QO) / 2, C2};
        pg8::gemm_phase<pg8::EpiQKV<1>, pg8::StaticOrder, true, true>(F.lds + RING_OFF, g, So, E, F.wave);
    } SEAM(9);
    if (IN(10)) { swa_attn_simple(F, QO, KB, VB, QO, args.in[11], args.in[13]); } SEAM(10);
    if (IN(11)) {
        pg8::Gemm g{QO, (const pg8::bf16_t*)(ws + WS_WSWAOUT), M, D, D}; pg8::StaticOrder So; So.init(M, D, F.G, (int)blockIdx.x);
        pg8::EpiResid E{XA, XA, MOD1 + 2 * D, D, S, NMOD};
        pg8::gemm_phase<pg8::EpiResid, pg8::StaticOrder, true, true>(F.lds + RING_OFF, g, So, E, F.wave);
    } SEAM(11);
    if (IN(12)) { route_rows(F, XA, args.in[5] + D, MOD1 + 3 * D, MOD1 + 4 * D, args.in[16], args.in[17], XS, (int*)(ws + WS_LIST), (float*)(ws + WS_WL), F.ctl + CW_CNT); } SEAM(12);
    if (IN(13) || IN(14)) {
        volatile LAS int* tab = (volatile LAS int*)(F.lds + TAB_OFF);
        if (F.wave == 0 && pg8::pg8_lane_id() == 0) { int accp = 0;
            for (int e = 0; e < NE; ++e) { const int n = (int)__hip_atomic_load(F.ctl + CW_CNT + 64 * e, RLX_AGENT); tab[e] = accp; accp += (n + 255) >> 8; }
            tab[8] = accp; }
        __syncthreads();
    }
    if (IN(13)) {
        pg8::Gemm g{XS, (const pg8::bf16_t*)(ws + WS_WMGU), M, 2 * FF, D}; pg8::MoeOrder So; So.init((const LAS int*)(F.lds + TAB_OFF), 2 * FF / 256, F.G, (int)blockIdx.x, ECAP / 256);
        pg8::EpiSwiglu E{ACT2, FF};
        pg8::gemm_phase<pg8::EpiSwiglu, pg8::MoeOrder, true, true>(F.lds + RING_OFF, g, So, E, F.wave);
    } SEAM(13);
    if (IN(14)) {
        pg8::Gemm g{ACT2, (const pg8::bf16_t*)(ws + WS_WMDN), M, D, FF}; pg8::MoeOrder So; So.init((const LAS int*)(F.lds + TAB_OFF), D / 256, F.G, (int)blockIdx.x, 0);
        pg8::EpiScatter E{YS, (const int*)(ws + WS_LIST), (const float*)(ws + WS_WL), (const unsigned*)(F.ctl + CW_CNT), ECAP, 64};
        pg8::gemm_phase<pg8::EpiScatter, pg8::MoeOrder, true, true>(F.lds + RING_OFF, g, So, E, F.wave);
    } SEAM(14);
    if (IN(15)) { final_rows(F, XA, YS, MOD1 + 5 * D, args.in[6], args.out); }
#undef IN
#undef SEAM
}

extern "C" void kernel_launch(void* const* d_in, const int* in_sizes, int n_in, void* d_out, int out_size, void* d_ws, size_t ws_size, hipStream_t stream) {
    static int grid = 0;
    if (grid == 0) {
        if (n_in != 20 || out_size != M * D || ws_size < WS_END) { fprintf(stderr, "kernel_launch: unexpected problem (n_in %d, out %d, ws %zu)\n", n_in, out_size, ws_size); grid = -1; return; }
        int dev = 0, cus = 0, per_cu = 0;
        if (hipGetDevice(&dev) != hipSuccess || hipDeviceGetAttribute(&cus, hipDeviceAttributeMultiprocessorCount, dev) != hipSuccess) { grid = -1; return; }
        if (hipFuncSetAttribute((const void*)mk_fwd, hipFuncAttributeMaxDynamicSharedMemorySize, LDS_BYTES) != hipSuccess) { fprintf(stderr, "kernel_launch: hipFuncSetAttribute failed\n"); grid = -1; return; }
        if (hipOccupancyMaxActiveBlocksPerMultiprocessor(&per_cu, (const void*)mk_fwd, NWAVES * 64, LDS_BYTES) != hipSuccess || per_cu < 1) { fprintf(stderr, "kernel_launch: occupancy query reports %d\n", per_cu); (void)hipGetLastError(); grid = -1; return; }
        grid = cus;
    }
    if (grid < 0) return;
    if (hipMemsetAsync((char*)d_ws + WS_CTL, 0, CTL_ZERO_BYTES, stream) != hipSuccess) return;
    Args a{};
    for (int i = 0; i < 20; ++i) a.in[i] = (const float*)d_in[i];
    a.out = (float*)d_out; a.ws = (unsigned char*)d_ws; a.ph_lo = 0; a.ph_hi = 16;
    hipLaunchKernelGGL(mk_fwd, dim3(grid), dim3(NWAVES * 64), LDS_BYTES, stream, a);
}
```

```cpp
#include <hip/hip_runtime.h>
#include <cstdio>
#include <cstdint>
#include <cmath>
namespace pg8 {
#define PG8_LAS __attribute__((address_space(3)))
typedef unsigned short bf16_t;
typedef short bf16x8 __attribute__((ext_vector_type(8)));
typedef float f32x4 __attribute__((ext_vector_type(4)));
typedef unsigned u32x4 __attribute__((ext_vector_type(4)));
constexpr int BM = 256, BK = 64, HALF = 128, HTB = HALF * BK * 2  , STAGE_BYTES = 8 * HTB, NXCD = 8, WGM = 8;

__host__ __device__ __forceinline__ int lds_byte(int r, int c) { const int st = (r >> 4) * 2 + (c >> 5), rr = r & 15, cc = c & 31, ob = rr * 64 + cc * 2; return st * 1024 + (ob ^ (((ob >> 9) & 1) << 5)); }
__host__ __device__ __forceinline__ void stage_rc(int b, int& R, int& C) { const int st = b / 1024, sb = b % 1024, swz = sb ^ (((sb >> 9) & 1) << 5); R = (st >> 1) * 16 + swz / 64; C = (st & 1) * 32 + (swz % 64) / 2; }
__host__ __device__ __forceinline__ int perm32(int rho) { const int n = rho >> 4, i = rho & 15; return 8 * (i >> 2) + 4 * n + (i & 3); }
__device__ __forceinline__ int pg8_lane_id() { int l; asm volatile("v_mbcnt_lo_u32_b32 %0, -1, 0\n\tv_mbcnt_hi_u32_b32 %0, -1, %0" : "=v"(l)); return l; }
struct Unit { int pm, pn, orow, ocol, aux, mt; };
struct Gemm { const bf16_t* A; const bf16_t* Bt; int M, N, K; };

struct StaticOrder {
    int nM, nN, nwg, G, c;
    __device__ __forceinline__ void init(int M, int N, int G_, int c_) { nM = M / BM; nN = N / BM; nwg = nM * nN; G = G_; c = c_; }
    __device__ __forceinline__ bool next(int i, Unit& u) const {
        const long L = (long)i * G + c; if (L >= nwg) return false;
        int wgid = (int)L; { const int q = nwg / NXCD, r = nwg % NXCD, xcd = wgid % NXCD, off = wgid / NXCD; wgid = (xcd < r ? xcd * (q + 1) : r * (q + 1) + (xcd - r) * q) + off; }
        const int nig = WGM * nN, gid = wgid / nig, fm = gid * WGM, gsz = (nM - fm) < WGM ? (nM - fm) : WGM;
        u.pm = fm + ((wgid % nig) % gsz); u.pn = (wgid % nig) / gsz; u.orow = u.pm * BM; u.ocol = u.pn; u.aux = 0; u.mt = u.pm; return true;
    }
    __device__ __forceinline__ void a_ready(const Unit&) const {}
    __device__ __forceinline__ void done(const Unit&) const {}
};
struct MoeOrder {
    const PG8_LAS int* tab; int nN, G, c, TM, apt;
    __device__ __forceinline__ void init(const PG8_LAS int* tab_, int nN_, int G_, int c_, int apt_) { tab = tab_; nN = nN_; G = G_; c = c_; apt = apt_; TM = __builtin_amdgcn_readfirstlane(tab_[8]); }
    __device__ __forceinline__ bool next(int i, Unit& u) const {
        const int nwg = TM * nN; const long L = (long)i * G + c; if (L >= nwg) return false;
        int wgid = (int)L; { const int q = nwg / NXCD, r = nwg % NXCD, xcd = wgid % NXCD, off = wgid / NXCD; wgid = (xcd < r ? xcd * (q + 1) : r * (q + 1) + (xcd - r) * q) + off; }
        const int nig = WGM * nN, gid = wgid / nig, fm = gid * WGM, gsz = (TM - fm) < WGM ? (TM - fm) : WGM;
        const int gm = fm + ((wgid % nig) % gsz), pnl = (wgid % nig) / gsz;
        int e = 0;
#pragma unroll
        for (int j = 1; j < 8; ++j) e += (gm >= tab[j]) ? 1 : 0;
        e = __builtin_amdgcn_readfirstlane(e);
        const int t0 = __builtin_amdgcn_readfirstlane(tab[e]), mt = gm - t0;
        u.pm = apt ? e * apt + mt : t0 + mt; u.pn = e * nN + pnl; u.orow = (t0 + mt) * BM; u.ocol = pnl; u.aux = e; u.mt = mt; return true;
    }
    __device__ __forceinline__ void a_ready(const Unit&) const {}
    __device__ __forceinline__ void done(const Unit&) const {}
};

__device__ __forceinline__ unsigned cvt_pk_bf16(float lo, float hi) { unsigned r; asm volatile("v_cvt_pk_bf16_f32 %0, %1, %2" : "=v"(r) : "v"(lo), "v"(hi)); return r; }
__device__ __forceinline__ float silu_f(float v) { return v * __builtin_amdgcn_rcpf(1.0f + __builtin_amdgcn_exp2f(-1.4426950408889634f * v)); }

template <int MODE> struct EpiQKV {
    static constexpr bool PERM = true, AFTER_DRAIN = false;
    bf16_t* Q; size_t stride; float scale0;
    __device__ __forceinline__ void operator()(const f32x4 (&acc)[2][2][4][2], const Unit& u, int wr, int wc, int fr, int fq) const {
        const int pn = u.ocol; int t, ldc, colt;
        if (MODE == 0) { t = pn >> 2; ldc = 1024; colt = (pn & 3) * 256; }
        else { if (pn < 4) { t = 0; ldc = 1024; colt = pn * 256; } else { t = pn - 3; ldc = 256; colt = 0; } }
        bf16_t* base = Q + (size_t)t * stride; const float sc = (t == 0) ? scale0 : 1.f;
        const int row0 = u.orow + wr * 64 + fr, col0 = colt + wc * 32 + 8 * fq;
#pragma unroll
        for (int ai = 0; ai < 2; ++ai)
#pragma unroll
            for (int m = 0; m < 4; ++m) { bf16_t* rowp = base + (size_t)(row0 + ai * HALF + m * 16) * ldc + col0;
#pragma unroll
                for (int bj = 0; bj < 2; ++bj) { const f32x4 v0 = acc[ai][bj][m][0] * sc, v1 = acc[ai][bj][m][1] * sc;
                    u32x4 w; w.x = cvt_pk_bf16(v0[0], v0[1]); w.y = cvt_pk_bf16(v0[2], v0[3]); w.z = cvt_pk_bf16(v1[0], v1[1]); w.w = cvt_pk_bf16(v1[2], v1[3]);
                    *(u32x4*)(rowp + bj * HALF) = w; } }
    }
};
struct EpiResid {
    static constexpr bool PERM = false, AFTER_DRAIN = false;
    const float* xin; float* out; const float* gate; int ldc, rows_per_batch, gld;
    __device__ __forceinline__ void operator()(const f32x4 (&acc)[2][2][4][2], const Unit& u, int wr, int wc, int fr, int fq) const {
        const int row0 = u.orow + wr * 64 + fr, col0 = u.ocol * BM + wc * 32 + 4 * fq;
        const float* gp = gate + (size_t)(u.orow / rows_per_batch) * gld + col0;
        f32x4 gv[2][2];
#pragma unroll
        for (int bj = 0; bj < 2; ++bj)
#pragma unroll
            for (int n = 0; n < 2; ++n) gv[bj][n] = *(const f32x4*)(gp + bj * HALF + n * 16);
#pragma unroll
        for (int ai = 0; ai < 2; ++ai)
#pragma unroll
            for (int m = 0; m < 4; ++m) { const size_t off = (size_t)(row0 + ai * HALF + m * 16) * ldc + col0;
#pragma unroll
                for (int bj = 0; bj < 2; ++bj)
#pragma unroll
                    for (int n = 0; n < 2; ++n) { const f32x4 xv = *(const f32x4*)(xin + off + bj * HALF + n * 16); *(f32x4*)(out + off + bj * HALF + n * 16) = xv + gv[bj][n] * acc[ai][bj][m][n]; }
                asm volatile("" ::: "memory"); }
    }
};
struct EpiSwiglu {
    static constexpr bool PERM = true, AFTER_DRAIN = false;
    bf16_t* O; int ldc;
    __device__ __forceinline__ void operator()(const f32x4 (&acc)[2][2][4][2], const Unit& u, int wr, int wc, int fr, int fq) const {
        const int row0 = u.orow + wr * 64 + fr, col0 = u.ocol * HALF + wc * 32 + 8 * fq;
#pragma unroll
        for (int ai = 0; ai < 2; ++ai)
#pragma unroll
            for (int m = 0; m < 4; ++m) { bf16_t* rowp = O + (size_t)(row0 + ai * HALF + m * 16) * ldc + col0;
                const f32x4 g0 = acc[ai][0][m][0], g1 = acc[ai][0][m][1], u0 = acc[ai][1][m][0], u1 = acc[ai][1][m][1];
                u32x4 w; w.x = cvt_pk_bf16(silu_f(g0[0]) * u0[0], silu_f(g0[1]) * u0[1]); w.y = cvt_pk_bf16(silu_f(g0[2]) * u0[2], silu_f(g0[3]) * u0[3]);
                w.z = cvt_pk_bf16(silu_f(g1[0]) * u1[0], silu_f(g1[1]) * u1[1]); w.w = cvt_pk_bf16(silu_f(g1[2]) * u1[2], silu_f(g1[3]) * u1[3]);
                *(u32x4*)rowp = w; }
    }
};
struct EpiScatter {
    static constexpr bool PERM = true, AFTER_DRAIN = false;
    bf16_t* YS; const int* list; const float* wl; const unsigned* cnt; int lpitch, cstride;
    __device__ __forceinline__ void operator()(const f32x4 (&acc)[2][2][4][2], const Unit& u, int wr, int wc, int fr, int fq) const {
        const int e = u.aux, ne = (int)cnt[e * cstride], p0 = u.mt * BM + wr * 64 + fr, col0 = u.ocol * BM + wc * 32 + 8 * fq;
#pragma unroll
        for (int ai = 0; ai < 2; ++ai)
#pragma unroll
            for (int m = 0; m < 4; ++m) { const int p = p0 + ai * HALF + m * 16;
                if (p < ne) { const int t2 = list[e * lpitch + p]; const float w = wl[e * lpitch + p]; bf16_t* rowp = YS + (size_t)t2 * 1024 + col0;
#pragma unroll
                    for (int bj = 0; bj < 2; ++bj) { const f32x4 v0 = acc[ai][bj][m][0] * w, v1 = acc[ai][bj][m][1] * w;
                        u32x4 q; q.x = cvt_pk_bf16(v0[0], v0[1]); q.y = cvt_pk_bf16(v0[2], v0[3]); q.z = cvt_pk_bf16(v1[0], v1[1]); q.w = cvt_pk_bf16(v1[2], v1[3]);
                        *(u32x4*)(rowp + bj * HALF) = q; } } }
    }
};

template <class Epi, class Sched, bool ALIGN_EPI = false, bool SP2 = false>
__device__ __forceinline__ void gemm_phase(PG8_LAS unsigned char* lds, const Gemm g, const Sched& S, const Epi& E, const int wid) {
    const int lane = pg8_lane_id(), tid = wid * 64 + lane, wr = wid >> 2, wc = wid & 3, fr = lane & 15, fq = lane >> 4;
    const int K = g.K, nt = K / BK;
    unsigned voffA[2], voffB[2];
#pragma unroll
    for (int i = 0; i < 2; ++i) { int R, C; stage_rc(tid * 16 + i * 8192, R, C); const int Rb = Epi::PERM ? ((R & ~31) + perm32(R & 31)) : R;
        voffA[i] = (unsigned)(R * K + C) * 2u; voffB[i] = (unsigned)(Rb * K + C) * 2u; }
    const size_t kstep = (size_t)(BK * 2);
    const size_t hstep = (size_t)HALF * K * 2;
    const size_t tstep = 2 * hstep;
    const unsigned ldsw = (unsigned)wid * 1024u;
    const int aoff = lds_byte(wr * 64 + fr, fq * 8), boff = lds_byte(wc * 32 + fr, fq * 8);
#define PG8_SA(b, h) (((b) * 2 + (h)) * HTB)
#define PG8_SB(b, h) ((4 + (b) * 2 + (h)) * HTB)
#define PG8_STAGE(bufoff, gbase, voff) do { _Pragma("unroll") for (int _i = 0; _i < 2; ++_i) \
        __builtin_amdgcn_global_load_lds((const unsigned*)((const char*)(gbase) + (voff)[_i]), (PG8_LAS unsigned*)(lds + (bufoff) + ldsw + _i * 8192), 16, 0, 0); } while (0)
#define PG8_LDA(dst, b, h) do { _Pragma("unroll") for (int m = 0; m < 4; ++m) _Pragma("unroll") for (int k = 0; k < 2; ++k) dst[m][k] = *(const PG8_LAS bf16x8*)(lds + PG8_SA(b, h) + aoff + m * 2048 + k * 1024); } while (0)
#define PG8_LDB(dst, b, h) do { _Pragma("unroll") for (int n = 0; n < 2; ++n) _Pragma("unroll") for (int k = 0; k < 2; ++k) dst[n][k] = *(const PG8_LAS bf16x8*)(lds + PG8_SB(b, h) + boff + n * 2048 + k * 1024); } while (0)
#define PG8_MMA(ai, bj, At, Bt) do { __builtin_amdgcn_s_setprio(1); _Pragma("unroll") for (int m = 0; m < 4; ++m) _Pragma("unroll") for (int n = 0; n < 2; ++n) _Pragma("unroll") for (int k = 0; k < 2; ++k) \
        acc[ai][bj][m][n] = __builtin_amdgcn_mfma_f32_16x16x32_bf16(Bt[n][k], At[m][k], acc[ai][bj][m][n], 0, 0, 0); __builtin_amdgcn_s_setprio(0); } while (0)
#define PG8_WAIT_V(n) asm volatile("s_waitcnt vmcnt(" #n ")" ::: "memory")
#define PG8_WAIT_L(n) asm volatile("s_waitcnt lgkmcnt(" #n ")" ::: "memory")
#define PG8_BAR __builtin_amdgcn_s_barrier()
#define PG8_SCHED __builtin_amdgcn_sched_barrier(0)
    Unit cur, nxt; int ui = 0;
    if (!S.next(0, cur)) return;
    f32x4 acc[2][2][4][2];
#pragma unroll
    for (int a = 0; a < 2; ++a)
#pragma unroll
        for (int b = 0; b < 2; ++b)
#pragma unroll
            for (int m = 0; m < 4; ++m)
#pragma unroll
                for (int n = 0; n < 2; ++n) acc[a][b][m][n] = (f32x4){0.f, 0.f, 0.f, 0.f};
    bf16x8 At[4][2], B0[2][2], B1[2][2];
    const char* cA = (const char*)g.A + (size_t)cur.pm * tstep; const char* cB = (const char*)g.Bt + (size_t)cur.pn * tstep;
    S.a_ready(cur);
    if constexpr (SP2) {
        PG8_STAGE(PG8_SB(0, 0), cB, voffB); PG8_STAGE(PG8_SB(0, 1), cB + hstep, voffB); PG8_STAGE(PG8_SA(0, 0), cA, voffA); PG8_STAGE(PG8_SA(0, 1), cA + hstep, voffA);
        if (wr == 1) PG8_BAR;
        PG8_WAIT_V(2); PG8_BAR;
        PG8_STAGE(PG8_SB(1, 0), cB + kstep, voffB); PG8_STAGE(PG8_SA(1, 0), cA + kstep, voffA); PG8_STAGE(PG8_SB(1, 1), cB + hstep + kstep, voffB);
        PG8_WAIT_V(6); PG8_BAR;
    } else {
        PG8_STAGE(PG8_SB(0, 0), cB, voffB); PG8_STAGE(PG8_SA(0, 0), cA, voffA); PG8_STAGE(PG8_SB(0, 1), cB + hstep, voffB); PG8_STAGE(PG8_SA(0, 1), cA + hstep, voffA);
        if (wr == 1) PG8_BAR;
        PG8_WAIT_V(4); PG8_BAR;
        PG8_STAGE(PG8_SB(1, 0), cB + kstep, voffB); PG8_STAGE(PG8_SA(1, 0), cA + kstep, voffA); PG8_STAGE(PG8_SB(1, 1), cB + hstep + kstep, voffB);
        PG8_WAIT_V(6); PG8_BAR;
    }
    for (;;) {
        const bool has_next = S.next(ui + 1, nxt);
        const char* nA = has_next ? (const char*)g.A + (size_t)nxt.pm * tstep : cA; const char* nB = has_next ? (const char*)g.Bt + (size_t)nxt.pn * tstep : cB;
        for (int t = 0; t < nt; t += 2) {
            const bool last = (t == nt - 2);
            const char* a1 = cA + (size_t)(t + 1) * kstep;
            const char* a2 = last ? nA : cA + (size_t)(t + 2) * kstep; const char* b2 = last ? nB : cB + (size_t)(t + 2) * kstep;
            const char* a3 = a2 + kstep; const char* b3 = b2 + kstep;
            if (last && has_next) S.a_ready(nxt);
            if constexpr (SP2) {
            PG8_LDB(B0, 0, 0); PG8_LDB(B1, 0, 1); PG8_SCHED; PG8_LDA(At, 0, 0); PG8_STAGE(PG8_SA(1, 1), a1 + hstep, voffA);
            PG8_WAIT_V(8); PG8_WAIT_L(0); PG8_BAR; PG8_MMA(0, 0, At, B0); PG8_MMA(0, 1, At, B1); PG8_BAR; PG8_SCHED;
            PG8_LDA(At, 0, 1); PG8_STAGE(PG8_SB(0, 0), b2, voffB); PG8_STAGE(PG8_SB(0, 1), b2 + hstep, voffB); PG8_STAGE(PG8_SA(0, 0), a2, voffA);
            PG8_WAIT_V(8); PG8_WAIT_L(0); PG8_BAR; PG8_MMA(1, 0, At, B0); PG8_MMA(1, 1, At, B1); PG8_BAR; PG8_SCHED;
            PG8_LDB(B0, 1, 0); PG8_LDB(B1, 1, 1); PG8_SCHED; PG8_LDA(At, 1, 0); PG8_STAGE(PG8_SA(0, 1), a2 + hstep, voffA);
            PG8_WAIT_V(8); PG8_WAIT_L(0); PG8_BAR; PG8_MMA(0, 0, At, B0); PG8_MMA(0, 1, At, B1); PG8_BAR; PG8_SCHED;
            PG8_LDA(At, 1, 1); PG8_STAGE(PG8_SB(1, 0), b3, voffB); PG8_STAGE(PG8_SB(1, 1), b3 + hstep, voffB); PG8_STAGE(PG8_SA(1, 0), a3, voffA);
            PG8_WAIT_V(8); PG8_WAIT_L(0); PG8_BAR; PG8_MMA(1, 0, At, B0); PG8_MMA(1, 1, At, B1); PG8_BAR; PG8_SCHED;
            } else {
            PG8_LDB(B0, 0, 0); PG8_SCHED; PG8_LDA(At, 0, 0); PG8_STAGE(PG8_SA(1, 1), a1 + hstep, voffA);
            PG8_WAIT_L(8); PG8_BAR; PG8_WAIT_L(0); PG8_MMA(0, 0, At, B0); PG8_BAR; PG8_SCHED;
            PG8_LDB(B1, 0, 1); PG8_STAGE(PG8_SB(0, 0), b2, voffB);
            PG8_BAR; PG8_WAIT_L(0); PG8_MMA(0, 1, At, B1); PG8_BAR;
            PG8_LDA(At, 0, 1); PG8_STAGE(PG8_SA(0, 0), a2, voffA);
            PG8_BAR; PG8_WAIT_L(0); PG8_MMA(1, 0, At, B0); PG8_BAR; PG8_SCHED;
            PG8_STAGE(PG8_SB(0, 1), b2 + hstep, voffB);
            PG8_WAIT_V(6); PG8_BAR; PG8_MMA(1, 1, At, B1); PG8_BAR;
            PG8_LDB(B0, 1, 0); PG8_SCHED; PG8_LDA(At, 1, 0); PG8_STAGE(PG8_SA(0, 1), a2 + hstep, voffA);
            PG8_WAIT_L(8); PG8_BAR; PG8_WAIT_L(0); PG8_MMA(0, 0, At, B0); PG8_BAR; PG8_SCHED;
            PG8_LDB(B1, 1, 1); PG8_STAGE(PG8_SB(1, 0), b3, voffB);
            PG8_BAR; PG8_WAIT_L(0); PG8_MMA(0, 1, At, B1); PG8_BAR;
            PG8_LDA(At, 1, 1); PG8_STAGE(PG8_SA(1, 0), a3, voffA);
            PG8_BAR; PG8_WAIT_L(0); PG8_MMA(1, 0, At, B0); PG8_BAR; PG8_SCHED;
            PG8_STAGE(PG8_SB(1, 1), b3 + hstep, voffB);
            PG8_WAIT_V(6); PG8_BAR; PG8_MMA(1, 1, At, B1); PG8_BAR;
            }
        }
        if constexpr (ALIGN_EPI) { if (wr == 0) PG8_BAR; }
        if constexpr (!Epi::AFTER_DRAIN) { E(acc, cur, wr, wc, fr, fq); S.done(cur); }
        if (!has_next) break;
#pragma unroll
        for (int a = 0; a < 2; ++a)
#pragma unroll
            for (int b = 0; b < 2; ++b)
#pragma unroll
                for (int m = 0; m < 4; ++m)
#pragma unroll
                    for (int n = 0; n < 2; ++n) acc[a][b][m][n] = (f32x4){0.f, 0.f, 0.f, 0.f};
        cur = nxt; cA = nA; cB = nB; ++ui;
        if constexpr (ALIGN_EPI) { if (wr == 1) PG8_BAR; }
    }
    PG8_WAIT_V(0);
    if constexpr (!ALIGN_EPI) { if (wr == 0) PG8_BAR; }
    PG8_BAR;
    if constexpr (Epi::AFTER_DRAIN) { E.fused(acc, cur, wr, wc, fr, fq, lds, wid, lane); S.done(cur); }
#undef PG8_SA
#undef PG8_SB
#undef PG8_STAGE
#undef PG8_LDA
#undef PG8_LDB
#undef PG8_MMA
#undef PG8_WAIT_V
#undef PG8_WAIT_L
#undef PG8_BAR
#undef PG8_SCHED
}
}

#include <hip/hip_bf16.h>
namespace attn_body {
using bf16=__hip_bfloat16;
using bf16x8=__attribute__((ext_vector_type(8)))short;
using s16x4=__attribute__((ext_vector_type(4)))short;
using f32x16=__attribute__((ext_vector_type(16)))float;
using u32x4=__attribute__((ext_vector_type(4)))unsigned;
constexpr int BATCH=4,NHEAD=16,SEQ=4096,D=64,DM=NHEAD*D;
constexpr int NW=8,QBLK=32,QB=QBLK*NW,KVBLK=64,NQB=SEQ/QB;
constexpr int ATTN_PITCH=DM, ATTN_UNIT_ROWS=QB;
__device__ __forceinline__ int crow(int r,int hi){return (r&3)+8*(r>>2)+4*hi;}
#define SBAR() __builtin_amdgcn_sched_barrier(0)
__device__ __forceinline__ void cmask(f32x16&p0,f32x16&p1,int jb,int qrel,int hi){
  const float NEG=-INFINITY; int kb=64*jb+4*hi;
  #pragma unroll
  for(int r=0;r<16;++r){int kv=kb+(r&3)+8*(r>>2); if(kv>qrel)p0[r]=NEG; if(kv+32>qrel)p1[r]=NEG;}
}

constexpr int NSLOT=3, SLOTB=8192;
constexpr int LDS_K=0, LDS_V=NSLOT*SLOTB, LDS_WS=2*NSLOT*SLOTB, LDS_OST=LDS_WS+NW*64*4, LDS_BYTES=LDS_OST+NW*4096;
constexpr float C2=0.125f*1.4426950408889634f;
__device__ __forceinline__ void glds16(const void*gsrc,unsigned lds_dst){unsigned keep;
  asm volatile("s_mov_b32 %0, m0\n\ts_mov_b32 m0, %2\n\ts_nop 0\n\tglobal_load_lds_dwordx4 %1, off\n\ts_mov_b32 m0, %0":"=&s"(keep):"v"(gsrc),"s"(lds_dst):"memory");}
__device__ __forceinline__ float max3f(float a,float b,float c){float r;asm("v_max3_f32 %0, %1, %2, %3":"=v"(r):"v"(a),"v"(b),"v"(c));return r;}
__device__ __forceinline__ float max2f(float a,float b){float r;asm("v_max_f32_e32 %0, %1, %2":"=v"(r):"v"(a),"v"(b));return r;}
__device__ __forceinline__ float fadd_s(float a,float b){float r;asm("v_add_f32_e32 %0, %1, %2":"=v"(r):"v"(a),"v"(b));return r;}
__device__ __forceinline__ float fsub_s(float a,float b){float r;asm("v_sub_f32_e32 %0, %1, %2":"=v"(r):"v"(a),"v"(b));return r;}
typedef float f32x2_t __attribute__((ext_vector_type(2))); typedef __bf16 bf16x2_t __attribute__((ext_vector_type(2)));
__device__ __forceinline__ unsigned cvtpk_s(float lo,float hi){f32x2_t v={lo,hi};bf16x2_t b=__builtin_convertvector(v,bf16x2_t);return __builtin_bit_cast(unsigned,b);}
#define WAIT_BAR(N) asm volatile("s_waitcnt vmcnt(" #N ") lgkmcnt(0)\n\ts_barrier":::"memory")

__device__ __forceinline__ void qkt(f32x16&p0,f32x16&p1,const char*Kslot,const bf16x8*qr,int r32,int hi){
  const char*kb=Kslot+hi*1024+r32*16;
  #pragma unroll
  for(int d0=0;d0<4;++d0){
    const bf16x8 b0=*reinterpret_cast<const bf16x8*>(kb+d0*2048);
    const bf16x8 b1=*reinterpret_cast<const bf16x8*>(kb+d0*2048+512);
    p0=__builtin_amdgcn_mfma_f32_32x32x16_bf16(b0,qr[d0],p0,0,0,0);p1=__builtin_amdgcn_mfma_f32_32x32x16_bf16(b1,qr[d0],p1,0,0,0);}
}
typedef __attribute__((address_space(3))) const char* lds_cptr;
typedef short v4i16_t __attribute__((ext_vector_type(4)));
__device__ __forceinline__ void kload8(bf16x8*kf,lds_cptr kp){
  kf[0]=*(const __attribute__((address_space(3))) bf16x8*)(kp);      kf[1]=*(const __attribute__((address_space(3))) bf16x8*)(kp+512);
  kf[2]=*(const __attribute__((address_space(3))) bf16x8*)(kp+2048); kf[3]=*(const __attribute__((address_space(3))) bf16x8*)(kp+2560);
  kf[4]=*(const __attribute__((address_space(3))) bf16x8*)(kp+4096); kf[5]=*(const __attribute__((address_space(3))) bf16x8*)(kp+4608);
  kf[6]=*(const __attribute__((address_space(3))) bf16x8*)(kp+6144); kf[7]=*(const __attribute__((address_space(3))) bf16x8*)(kp+6656);
}
__device__ __forceinline__ void kload2(bf16x8*kf,lds_cptr kp,int j){ kf[2*j]=*(const __attribute__((address_space(3))) bf16x8*)(kp+j*2048); kf[2*j+1]=*(const __attribute__((address_space(3))) bf16x8*)(kp+j*2048+512); }
__device__ __forceinline__ s16x4 vtr(lds_cptr p){ return __builtin_bit_cast(s16x4,__builtin_amdgcn_ds_read_tr16_b64_v4i16((__attribute__((address_space(3))) v4i16_t*)p)); }
__device__ __forceinline__ float rowmax(const f32x16&p0,const f32x16&p1){
  float a=max3f(p0[0],p0[1],p1[0]),b=max3f(p0[2],p0[3],p1[1]);a=max3f(a,p1[2],p1[3]);
  #pragma unroll
  for(int r=4;r<16;r+=4){a=max3f(a,p0[r],p0[r+1]);b=max3f(b,p0[r+2],p0[r+3]);a=max3f(a,p1[r],p1[r+1]);b=max3f(b,p1[r+2],p1[r+3]);}
  const float m=max2f(a,b);
  auto rr=__builtin_amdgcn_permlane32_swap(__float_as_uint(m),__float_as_uint(m),false,false);
  return max2f(__uint_as_float(rr[0]),__uint_as_float(rr[1]));
}
__device__ __forceinline__ void pv(f32x16*o,int vb,bf16x8 pa0,bf16x8 pa1,bf16x8 pa2,bf16x8 pa3){
  #pragma unroll
  for(int d0=0;d0<2;++d0){s16x4 lo[4],hi[4];
    #pragma unroll
    for(int ks=0;ks<4;++ks){
      asm volatile("ds_read_b64_tr_b16 %0,%1 offset:%c2":"=&v"(lo[ks]):"v"(vb),"i"(d0*4096+ks*1024):"memory");
      asm volatile("ds_read_b64_tr_b16 %0,%1 offset:%c2":"=&v"(hi[ks]):"v"(vb),"i"(d0*4096+ks*1024+512):"memory");}
    asm volatile("s_waitcnt lgkmcnt(0)":::"memory");SBAR();
    #define PK(k) (bf16x8){lo[k][0],lo[k][1],lo[k][2],lo[k][3],hi[k][0],hi[k][1],hi[k][2],hi[k][3]}
    o[d0]=__builtin_amdgcn_mfma_f32_32x32x16_bf16(pa0,PK(0),o[d0],0,0,0);
    o[d0]=__builtin_amdgcn_mfma_f32_32x32x16_bf16(pa1,PK(1),o[d0],0,0,0);
    o[d0]=__builtin_amdgcn_mfma_f32_32x32x16_bf16(pa2,PK(2),o[d0],0,0,0);
    o[d0]=__builtin_amdgcn_mfma_f32_32x32x16_bf16(pa3,PK(3),o[d0],0,0,0);
    #undef PK
  }
}

#ifndef ATTN_STORE16
#define ATTN_STORE16(p,v) (*(u32x4*)(p)=(v))
#endif
typedef __attribute__((address_space(3))) const float* lds_cfptr; typedef float f32x4_t __attribute__((ext_vector_type(4)));
constexpr float MFLOOR=-100.f;
template<int THRL> __device__ __forceinline__ void attn_unit(int b,int h,int qb,const bf16*Q,const bf16*__restrict__ K,const bf16*__restrict__ V,bf16*O,char*shm,lds_cfptr cum,const int wid){
  const int lane=pg8::pg8_lane_id(),r32=lane&31,hi=lane>>5;
  const long rowbase=(long)b*SEQ; const int q0=qb*QB;
  const bf16*Qw=Q+(rowbase+q0+wid*QBLK)*DM+h*D;
  const bf16*Kh=K+rowbase*DM+h*D,*Vh=V+rowbase*DM+h*D;
  const unsigned lds0=(unsigned)(uintptr_t)shm;
  float*wsf=(float*)(shm+LDS_WS)+wid*64;
  const bf16*ksrc=Kh+(long)lane*DM+wid*8;
  const bf16*vsrc=Vh+(long)(16*(wid&3)+(lane>>2))*DM+(wid>>2)*32+(lane&3)*8;
  const unsigned kdst=lds0+LDS_K+wid*1024, vdst=lds0+LDS_V+wid*1024;
  #define DMA_K(t,slot) glds16(ksrc+(long)(NT-1-(t))*KVBLK*DM,(unsigned)__builtin_amdgcn_readfirstlane(kdst+(slot)))
  #define DMA_V(t,slot) glds16(vsrc+(long)(NT-1-(t))*KVBLK*DM,(unsigned)__builtin_amdgcn_readfirstlane(vdst+(slot)))
  const char*Kbase=shm+LDS_K; bf16x8 kf[8];
  const lds_cptr shm3=(lds_cptr)shm; const lds_cptr kp0=shm3+LDS_K+hi*1024+r32*16; const lds_cptr vp0=shm3+LDS_V+((lane>>4)&1)*32+(lane&3)*8+(4*hi+((lane&15)>>2))*64;
  const int NT=(q0+QB)/KVBLK;
  DMA_K(0,0);DMA_V(0,0);DMA_K(1,SLOTB);
  bf16x8 qr[4];
  #pragma unroll
  for(int d0=0;d0<4;++d0)qr[d0]=*reinterpret_cast<const bf16x8*>(&Qw[(long)r32*DM+d0*16+hi*8]);
  float l_reg=0.f;f32x16 o[2];o[0]=f32x16{};o[1]=f32x16{};
  float cbase=cum[q0+wid*QBLK+r32];
  #define CINITH(CX,t,OFS) do{ const lds_cfptr cb_=cum+(NT-1-(t))*KVBLK+4*hi+(OFS); const float bs_=cbase; \
    _Pragma("unroll") for(int g_=0;g_<4;++g_){ const f32x4_t a_=*(const __attribute__((address_space(3))) f32x4_t*)(cb_+8*g_); \
      CX[4*g_]=bs_-a_[0];CX[4*g_+1]=bs_-a_[1];CX[4*g_+2]=bs_-a_[2];CX[4*g_+3]=bs_-a_[3]; } }while(0)
  #define CINIT(C0,C1,t) do{ CINITH(C0,t,0); CINITH(C1,t,32); }while(0)
  const int qrel=wid*QBLK+r32;
  #define CMASK(P0,P1,t) do{int jb_=3-(t); if(jb_>=0)cmask(P0,P1,jb_,qrel,hi);}while(0)
  bool resc=false;
  #define START(P0,P1) do{ const float rm=rowmax(P0,P1); resc=false; \
    { const float dl=max2f(rm,MFLOOR); cbase=fsub_s(cbase,dl); \
      _Pragma("unroll") for(int r=0;r<16;++r){P0[r]=fsub_s(P0[r],dl);P1[r]=fsub_s(P1[r],dl);} } \
    _Pragma("unroll") for(int r=0;r<16;++r)P0[r]=__builtin_amdgcn_exp2f(P0[r]); }while(0)
  #define RESC() do{ if(resc){ asm volatile("s_waitcnt lgkmcnt(0)":::"memory"); const int hx_=pg8::pg8_lane_id()>>5; \
      _Pragma("unroll") for(int d_=0;d_<2;++d_) _Pragma("unroll") for(int r=0;r<16;++r)o[d_][r]*=wsf[crow(r,hx_)]; } }while(0)
  f32x16 pA0,pA1,pB0,pB1;
  int sl_prev=0,sl_cur=0,sl_next=SLOTB;
  #define ROT() do{sl_prev=sl_cur;sl_cur=sl_next;sl_next=(sl_next==(NSLOT-1)*SLOTB)?0:sl_next+SLOTB;}while(0)
  DMA_K(2,2*SLOTB);
  WAIT_BAR(3);
  CINIT(pA0,pA1,0); qkt(pA0,pA1,Kbase,qr,r32,hi);asm volatile("s_nop 15\n\ts_nop 7":"+v"(pA0),"+v"(pA1));CMASK(pA0,pA1,0);
  START(pA0,pA1);
  _Pragma("unroll") for(int r=0;r<16;++r)pA1[r]=__builtin_amdgcn_exp2f(pA1[r]);
  WAIT_BAR(0);
  DMA_K(3,0);DMA_V(1,SLOTB);
  ROT();
  kload8(kf,kp0+sl_cur);
  WAIT_BAR(2);
  s16x4 vlo[8],vhi[8]; u32x4 pw0,pw1,pw2,pw3;
  #define PKW(P,B) cvtpk_s(P[B],P[B+1])
  #define PAF(k) __builtin_bit_cast(bf16x8,pw##k)
  #define VFR(i) (bf16x8){vlo[i][0],vlo[i][1],vlo[i][2],vlo[i][3],vhi[i][0],vhi[i][1],vhi[i][2],vhi[i][3]}
  #define PIN(x) asm volatile("":"+v"(x))
  #define MX3(a,b,c) __builtin_fmaxf(__builtin_fmaxf((a),(b)),(c))
  #define GAPA(MF,A0,A1,A2,A3,W0,W1,PW) do{ MF; sacc+=A0; sacc+=A1; sacc+=A2; sacc+=A3; PIN(sacc); W0; W1; PIN(PW); SBAR(); }while(0)
  #define EX(v) __builtin_amdgcn_exp2f(v)
  #define GAPB(MF,X,B) do{ MF; X[B]=EX(X[B]); X[B+1]=EX(X[B+1]); X[B+2]=EX(X[B+2]); X[B+3]=EX(X[B+3]); PIN(X); SBAR(); }while(0)
  #define VRD(i) do{ vlo[i]=vtr(vp_+(((i)>>2)*4096+((i)&3)*1024)); vhi[i]=vtr(vp_+(((i)>>2)*4096+((i)&3)*1024+512)); }while(0)
  #define KRD(G,j) do{ if(G){ kload2(kf,kp0+sl_next,j); SBAR(); } }while(0)
  #define STEP(C0,C1,P0,P1,t,GK,GV,GL) do{ CINITH(C0,t,0); SBAR(); \
    const lds_cptr vp_=vp0+sl_prev; \
    VRD(0); SBAR(); float sacc=(P0[0]+P0[1]); \
    GAPA(C0=__builtin_amdgcn_mfma_f32_32x32x16_bf16(kf[0],qr[0],C0,0,0,0), P0[2],P0[3],P0[4],P0[5],     pw0[0]=PKW(P0,0), pw0[1]=PKW(P0,2), pw0); \
    CINITH(C1,t,32); SBAR(); VRD(4); SBAR(); GAPA(C1=__builtin_amdgcn_mfma_f32_32x32x16_bf16(kf[1],qr[0],C1,0,0,0), P0[6],P0[7],P0[8],P0[9],     pw0[2]=PKW(P0,4), pw0[3]=PKW(P0,6), pw0); \
    VRD(1); SBAR(); GAPA(C0=__builtin_amdgcn_mfma_f32_32x32x16_bf16(kf[2],qr[1],C0,0,0,0),   P0[10],P0[11],P0[12],P0[13], pw1[0]=PKW(P0,8), pw1[1]=PKW(P0,10), pw1); \
    VRD(5); SBAR(); GAPA(C1=__builtin_amdgcn_mfma_f32_32x32x16_bf16(kf[3],qr[1],C1,0,0,0),   P0[14],P0[15],P1[0],P1[1],   pw1[2]=PKW(P0,12),pw1[3]=PKW(P0,14), pw1); \
    VRD(2); SBAR(); GAPA(C0=__builtin_amdgcn_mfma_f32_32x32x16_bf16(kf[4],qr[2],C0,0,0,0),   P1[2],P1[3],P1[4],P1[5],     pw2[0]=PKW(P1,0), pw2[1]=PKW(P1,2), pw2); \
    VRD(6); SBAR(); GAPA(C1=__builtin_amdgcn_mfma_f32_32x32x16_bf16(kf[5],qr[2],C1,0,0,0),   P1[6],P1[7],P1[8],P1[9],     pw2[2]=PKW(P1,4), pw2[3]=PKW(P1,6), pw2); \
    VRD(3); SBAR(); GAPA(C0=__builtin_amdgcn_mfma_f32_32x32x16_bf16(kf[6],qr[3],C0,0,0,0),   P1[10],P1[11],P1[12],P1[13], pw3[0]=PKW(P1,8), pw3[1]=PKW(P1,10), pw3); \
    VRD(7); SBAR(); GAPA(C1=__builtin_amdgcn_mfma_f32_32x32x16_bf16(kf[7],qr[3],C1,0,0,0),   P1[14],P1[15],0.f,0.f,       pw3[2]=PKW(P1,12),pw3[3]=PKW(P1,14), pw3); \
    l_reg+=sacc; \
    if(GK){DMA_K((t)+3,sl_cur);} if(GV){DMA_V((t)+1,sl_next);} \
    CMASK(C0,C1,t); \
    { float a=MX3(C0[0],C0[1],C1[0]),b=MX3(C0[2],C0[3],C1[1]); a=MX3(a,C1[2],C1[3]); \
      _Pragma("unroll") for(int r=4;r<16;r+=4){a=MX3(a,C0[r],C0[r+1]);b=MX3(b,C0[r+2],C0[r+3]);a=MX3(a,C1[r],C1[r+1]);b=MX3(b,C1[r+2],C1[r+3]);} \
      float rm=__builtin_fmaxf(a,b); { auto rr=__builtin_amdgcn_permlane32_swap(__float_as_uint(rm),__float_as_uint(rm),false,false); rm=__builtin_fmaxf(__uint_as_float(rr[0]),__uint_as_float(rr[1])); } \
      resc=false; \
      if(__builtin_expect(__any(rm>(float)THRL),0)){ const float dl=__builtin_fmaxf(rm,0.f); cbase-=dl; \
        _Pragma("unroll") for(int r=0;r<16;++r){C0[r]-=dl;C1[r]-=dl;} \
        const float f=__builtin_amdgcn_exp2f(-dl); l_reg*=f; { const int lx_=pg8::pg8_lane_id(); if(lx_<32)wsf[lx_]=f; } resc=true; } } \
    SBAR(); \
    GAPB(o[0]=__builtin_amdgcn_mfma_f32_32x32x16_bf16(PAF(0),VFR(0),o[0],0,0,0), C0,0); \
    GAPB(o[1]=__builtin_amdgcn_mfma_f32_32x32x16_bf16(PAF(0),VFR(4),o[1],0,0,0), C0,4); \
    KRD(GL,0); GAPB(o[0]=__builtin_amdgcn_mfma_f32_32x32x16_bf16(PAF(1),VFR(1),o[0],0,0,0), C0,8); \
    KRD(GL,1); GAPB(o[1]=__builtin_amdgcn_mfma_f32_32x32x16_bf16(PAF(1),VFR(5),o[1],0,0,0), C0,12); \
    KRD(GL,2); GAPB(o[0]=__builtin_amdgcn_mfma_f32_32x32x16_bf16(PAF(2),VFR(2),o[0],0,0,0), C1,0); \
    KRD(GL,3); GAPB(o[1]=__builtin_amdgcn_mfma_f32_32x32x16_bf16(PAF(2),VFR(6),o[1],0,0,0), C1,4); \
    GAPB(o[0]=__builtin_amdgcn_mfma_f32_32x32x16_bf16(PAF(3),VFR(3),o[0],0,0,0), C1,8); \
    GAPB(o[1]=__builtin_amdgcn_mfma_f32_32x32x16_bf16(PAF(3),VFR(7),o[1],0,0,0), C1,12); \
    }while(0)
  int t=1;
  #define ENDW(tt) do{ if((tt)+3<NT){WAIT_BAR(2);} else if((tt)+2<NT){WAIT_BAR(1);} else {WAIT_BAR(0);} }while(0)
  for(;t<5&&t+1<NT;t+=2){
    STEP(pB0,pB1,pA0,pA1,t,(t+3<NT),(t+1<NT),(t+1<NT));       ENDW(t);   RESC(); ROT();
    STEP(pA0,pA1,pB0,pB1,t+1,(t+4<NT),(t+2<NT),(t+2<NT));     ENDW(t+1); RESC(); ROT();
  }
  #undef CMASK
  #define CMASK(P0,P1,t) do{}while(0)
  for(;t+5<NT;t+=2){
    STEP(pB0,pB1,pA0,pA1,t,true,true,true);     WAIT_BAR(2); RESC(); ROT();
    STEP(pA0,pA1,pB0,pB1,t+1,true,true,true);   WAIT_BAR(2); RESC(); ROT();
  }
  for(;t+1<NT;t+=2){
    STEP(pB0,pB1,pA0,pA1,t,(t+3<NT),(t+1<NT),(t+1<NT));       ENDW(t);   RESC(); ROT();
    STEP(pA0,pA1,pB0,pB1,t+1,(t+4<NT),(t+2<NT),(t+2<NT));     ENDW(t+1); RESC(); ROT();
  }
  #undef CMASK
  #define CMASK(P0,P1,t) do{int jb_=3-(t); if(jb_>=0)cmask(P0,P1,jb_,qrel,hi);}while(0)
  STEP(pB0,pB1,pA0,pA1,NT-1,false,false,false); RESC();
  { float sacc=pB0[0]+pB0[1]; _Pragma("unroll") for(int r=2;r<16;++r)sacc+=pB0[r]; _Pragma("unroll") for(int r=0;r<16;++r)sacc+=pB1[r]; l_reg+=sacc;
    pw0=(u32x4){PKW(pB0,0),PKW(pB0,2),PKW(pB0,4),PKW(pB0,6)};pw1=(u32x4){PKW(pB0,8),PKW(pB0,10),PKW(pB0,12),PKW(pB0,14)};pw2=(u32x4){PKW(pB1,0),PKW(pB1,2),PKW(pB1,4),PKW(pB1,6)};pw3=(u32x4){PKW(pB1,8),PKW(pB1,10),PKW(pB1,12),PKW(pB1,14)};
    SBAR(); const int ld_=pg8::pg8_lane_id(); const int vb0=(int)(lds0+LDS_V)+((ld_>>4)&1)*32+(ld_&3)*8+(4*(ld_>>5)+((ld_&15)>>2))*64; pv(o,vb0+sl_cur,PAF(0),PAF(1),PAF(2),PAF(3)); }
  #undef PKW
  #undef PAF
  #undef VFR
  #undef PIN
  #undef MX3
  #undef GAPA
  #undef GAPB
  #undef EX
  #undef VRD
  #undef KRD
  #undef STEP
  #undef ENDW
  {auto rr=__builtin_amdgcn_permlane32_swap(__float_as_uint(l_reg),__float_as_uint(l_reg),false,false);l_reg=__uint_as_float(rr[0])+__uint_as_float(rr[1]);}
  const int le_=pg8::pg8_lane_id(),r32e=le_&31,hie=le_>>5;
  if(hie==0)wsf[32+r32e]=l_reg;asm volatile("s_waitcnt lgkmcnt(0)":::"memory");
  float rli[16];
  #pragma unroll
  for(int r=0;r<16;++r)rli[r]=__builtin_amdgcn_rcpf(wsf[32+crow(r,hie)]);
  bf16*Ow=O+(rowbase+q0+wid*QBLK)*DM+h*D;
  { bf16*stg=(bf16*)(shm+LDS_OST)+wid*2048;
    #pragma unroll
    for(int r=0;r<16;++r){const int orow=crow(r,hie);
      #pragma unroll
      for(int d0=0;d0<2;++d0)stg[orow*64+d0*32+r32e]=__float2bfloat16(o[d0][r]*rli[r]);}
    asm volatile("s_waitcnt lgkmcnt(0)":::"memory");
    #pragma unroll
    for(int i=0;i<4;++i){const int row=i*8+(le_>>3),ch=le_&7; const u32x4 v=*(const u32x4*)(stg+row*64+ch*8); ATTN_STORE16(Ow+(long)row*DM+ch*8,v);} }
  asm volatile("s_waitcnt lgkmcnt(0)\n\ts_barrier":::"memory");
  #undef DMA_K
  #undef DMA_V
  #undef CMASK
  #undef START
  #undef RESC
  #undef ROT
  #undef CINIT
  #undef CINITH
}
constexpr int ATTN_LDS_BYTES=LDS_BYTES;
struct AttnTensors { const bf16* Q; const bf16* K; const bf16* V; bf16* O; };
struct AttnUnit { int bh; int qb; };
__device__ __forceinline__ void attn_phase(char*lds,const AttnTensors&T,const float*logft,__attribute__((address_space(3))) float*cum,__attribute__((address_space(3))) float*part,int v,int G,const int wid){
  typedef float f4 __attribute__((ext_vector_type(4)));
  for(int pb=v;pb<BATCH*NHEAD*4;pb+=G){
    const int bh=pb>>2,s=pb&3;
    { const int lane=pg8::pg8_lane_id(),tid=wid*64+lane;
      const f4*p=(const f4*)(logft+(size_t)bh*SEQ)+2*tid; const f4 a=p[0],b=p[1];
      float w[8]; w[0]=a.x; w[1]=w[0]+a.y; w[2]=w[1]+a.z; w[3]=w[2]+a.w; w[4]=w[3]+b.x; w[5]=w[4]+b.y; w[6]=w[5]+b.z; w[7]=w[6]+b.w;
      float incl=w[7];
      #pragma unroll
      for(int o=1;o<64;o<<=1){ const float t_=__builtin_bit_cast(float,__builtin_amdgcn_ds_bpermute((lane-o)*4,__builtin_bit_cast(int,incl))); if(lane>=o)incl+=t_; }
      if(lane==63)part[wid]=incl;
      __syncthreads();
      float base=incl-w[7];
      #pragma unroll
      for(int k=0;k<8;++k) if(k<wid) base+=part[k];
      #pragma unroll
      for(int k=0;k<8;++k) cum[8*tid+k]=w[k]+base;
      __syncthreads(); }
    #pragma unroll 1
    for(int i=0;i<4;++i){ const int qb=(i==0)?s:(i==1)?7-s:(i==2)?8+s:15-s; attn_unit<8>(bh/NHEAD,bh%NHEAD,qb,T.Q,T.K,T.V,T.O,lds,(lds_cfptr)cum,wid); }
    __syncthreads();
  }
}
#undef SBAR
#undef WAIT_BAR
}

constexpr int NWAVES = 8;
constexpr int D = 1024, NB = 4, S = 4096, M = NB * S, FF = 3584, NE = 8, NH = 16;
constexpr int NMOD = 6 * D;
constexpr float C2 = 0.125f * 1.4426950408889634f;
constexpr float LOG2E = 1.4426950408889634f;
constexpr float RMS_EPS = 1e-6f;
constexpr int ECAP = 16384;

constexpr size_t MiB = 1u << 20;
constexpr size_t WS_CTL = 0, CTL_ZERO_BYTES = 1 * MiB;
constexpr size_t WS_MOD = 1 * MiB;
constexpr size_t WS_WFT = 1 * MiB + 512 * 1024;
constexpr size_t WS_LIST = 2 * MiB, WS_WL = 2 * MiB + 512 * 1024;
constexpr size_t WS_LOGFT = 3 * MiB;
constexpr size_t WS_WFOXIN = 4 * MiB, WS_WFOXOUT = 10 * MiB, WS_WSWAIN = 12 * MiB, WS_WSWAOUT = 15 * MiB, WS_WGU = 17 * MiB, WS_WDN = 31 * MiB;
constexpr size_t WS_WMGU = 38 * MiB, WS_WMDN = 150 * MiB;
constexpr size_t WS_XA = 206 * MiB;
constexpr size_t WS_YS = 270 * MiB;
constexpr size_t WS_XN = 334 * MiB;
constexpr size_t WS_QO = 366 * MiB, WS_K = 398 * MiB, WS_V = 430 * MiB;
constexpr size_t WS_ACT = 462 * MiB;
constexpr size_t WS_XS = 334 * MiB;
constexpr size_t WS_ACT2 = 590 * MiB;
constexpr size_t WS_END = 828 * MiB;
constexpr int CW_TMO = 0, CW_CODE = 1, CW_BAR = 4096, CW_CNT = 16384;
constexpr int RING_OFF = 0, RING_BYTES = 131072;
constexpr int LDSCTL_OFF = RING_BYTES, MISC_OFF = LDSCTL_OFF + 320;
constexpr int TAB_OFF = MISC_OFF + 128;
constexpr int RT_OFF = TAB_OFF + 128;
constexpr int LDS_BYTES = 147456;
static_assert(RT_OFF + 128 <= LDS_BYTES, "LDS map");

#define GAS __attribute__((address_space(1)))
#define LAS __attribute__((address_space(3)))
typedef unsigned short bf16;
typedef unsigned v4u __attribute__((ext_vector_type(4)));
typedef float f32x4 __attribute__((ext_vector_type(4)));
typedef short bf16x8 __attribute__((ext_vector_type(8)));
typedef GAS unsigned gu32;
typedef GAS unsigned long long gu64;
#define RLX_AGENT __ATOMIC_RELAXED, __HIP_MEMORY_SCOPE_AGENT
#define LDS_WAIT() asm volatile("s_waitcnt lgkmcnt(0)" ::: "memory")
#define VM_WAIT() asm volatile("s_waitcnt vmcnt(0)" ::: "memory")
__device__ __forceinline__ unsigned long long rt() { return __builtin_amdgcn_s_memrealtime(); }
__device__ __forceinline__ unsigned f2bf(float f) { unsigned u = __builtin_bit_cast(unsigned, f); return (u + 0x7fffu + ((u >> 16) & 1u)) >> 16; }
__device__ __forceinline__ unsigned pk2(float lo, float hi) { return f2bf(lo) | (f2bf(hi) << 16); }
#define XB_TMO      128
#define XB_XCNT(j)  (256  + 64 * (j))
#define XB_XSUB(j)  (1280 + 64 * (j))
#define XB_XGEN(j)  (2304 + 64 * (j))
#define XB_TOP      3328
#define XB_TOPGEN   3392
#define XCD_BAR_WORDS 3456
#define XB_SPIN_CAP (1u << 18)

__device__ __forceinline__ unsigned xb_ld(unsigned* p)              { return __hip_atomic_load(p, __ATOMIC_RELAXED, __HIP_MEMORY_SCOPE_AGENT); }
__device__ __forceinline__ unsigned xb_add(unsigned* p, unsigned v) { return __hip_atomic_fetch_add(p, v, __ATOMIC_RELAXED, __HIP_MEMORY_SCOPE_AGENT); }
__device__ __forceinline__ unsigned xb_xcc_id() { return (unsigned)__builtin_amdgcn_s_getreg((3 << 11) | 20) & 0xFu; }
#define XB_SPIN(cond, bar) do { unsigned _sp = 0; while (cond) { __builtin_amdgcn_s_sleep(1); \
    if ((++_sp & 255u) == 0u) { if (xb_ld(&(bar)[XB_TMO])) break; if (_sp > XB_SPIN_CAP) { atomicAdd(&(bar)[XB_TMO], 1u); break; } } } } while (0)

struct XcdBarrier {
    unsigned* bar; unsigned x;
    volatile LAS unsigned* st;
};

__device__ __forceinline__ XcdBarrier xcd_barrier_post(unsigned* bar, volatile LAS unsigned* st, const bool xb_leader) {
    XcdBarrier b; b.bar = bar; b.x = xb_xcc_id(); b.st = st;
    if (xb_leader) (void)xb_add(&bar[XB_XCNT(b.x)], 1u);
    return b;
}
__device__ __forceinline__ void xcd_barrier_complete(unsigned* bar, unsigned x, unsigned& nloc, unsigned& nx) {
    const unsigned G = gridDim.x * gridDim.y * gridDim.z;
    unsigned sum, cnt, mine, sp = 0u;
    for (;;) {
        sum = 0u; cnt = 0u; mine = 0u;
#pragma unroll
        for (unsigned j = 0; j < 16; ++j) { const unsigned c = xb_ld(&bar[XB_XCNT(j)]); sum += c; cnt += (c > 0u) ? 1u : 0u; mine = (j == x) ? c : mine; }
        if (sum == G) break;
        __builtin_amdgcn_s_sleep(1);
        if ((++sp & 255u) == 0u) { if (xb_ld(&bar[XB_TMO])) break; if (sp > XB_SPIN_CAP) { atomicAdd(&bar[XB_TMO], 1u); break; } }
    }
    nloc = mine > 0u ? mine : 1u; nx = cnt > 0u ? cnt : 1u;
}

__device__ __forceinline__ void xcd_barrier(const XcdBarrier& b, const bool xb_leader) {
    asm volatile("s_waitcnt vmcnt(0)" ::: "memory");
    __syncthreads();
    if (xb_leader) {
        unsigned* bar = b.bar;
        __builtin_amdgcn_s_waitcnt(0);
        unsigned nloc = b.st[0], nx = b.st[1];
        if (nloc == 0u) { xcd_barrier_complete(bar, b.x, nloc, nx); b.st[0] = nloc; b.st[1] = nx; }
        const unsigned old = xb_add(&bar[XB_XSUB(b.x)], 1u);
        const unsigned gen = old / nloc;
        if (old + 1u == (gen + 1u) * nloc) {
            __builtin_amdgcn_fence(__ATOMIC_RELEASE, "agent");
            asm volatile("s_waitcnt vmcnt(0)" ::: "memory");
            const unsigned og = xb_add(&bar[XB_TOP], 1u);
            const unsigned tg = og / nx;
            if (og + 1u == (tg + 1u) * nx) xb_add(&bar[XB_TOPGEN], 1u);
            else XB_SPIN(xb_ld(&bar[XB_TOPGEN]) == tg, bar);
            __builtin_amdgcn_fence(__ATOMIC_ACQUIRE, "agent");
            xb_add(&bar[XB_XGEN(b.x)], 1u);
            asm volatile("s_waitcnt vmcnt(0)" ::: "memory");
        } else {
            XB_SPIN(xb_ld(&bar[XB_XGEN(b.x)]) == gen, bar);
            __builtin_amdgcn_fence(__ATOMIC_ACQUIRE, "agent");
            asm volatile("s_waitcnt vmcnt(0)" ::: "memory");
        }
    }
    __syncthreads();
}

struct Frame {
    LAS unsigned char* lds;
    volatile LAS unsigned* MISC;
    gu32* ctl;
    unsigned char* ws;
    int wave;
    int vcu, G;
};
struct Args { const float* in[20]; float* out; unsigned char* ws; int ph_lo, ph_hi; };

__device__ __forceinline__ float wave_sum(float v) {
#pragma unroll
    for (int o = 1; o < 64; o <<= 1) v += __shfl_xor(v, o);
    return v;
}
__device__ __forceinline__ float bf_lo(unsigned w) { return __uint_as_float(w << 16); }
__device__ __forceinline__ float bf_hi(unsigned w) { return __uint_as_float(w & 0xffff0000u); }

__device__ __forceinline__ void tr_item(const float* W, int ld, int K, int nblk, int item, bf16* WT, bool gu, LAS float* scr, int lane) {
    const int kb = item / nblk, nb = item % nblk, k0 = 64 * kb, n0 = 32 * nb;
    int drow0 = n0;
    if (gu) { const int bj = n0 / FF, j = n0 - bj * FF; drow0 = 256 * (j / 128) + 128 * bj + (j % 128); }
#pragma unroll 8
    for (int i = 0; i < 32; ++i) { const int kk = 2 * i + (lane >> 5); scr[kk * 33 + (lane & 31)] = W[(size_t)(k0 + kk) * ld + n0 + (lane & 31)]; }
    LDS_WAIT(); asm volatile("" ::: "memory");
    const int c = lane & 7;
#pragma unroll
    for (int j = 0; j < 4; ++j) { const int n = (lane >> 3) + 8 * j; const LAS float* s = scr + (8 * c) * 33 + n;
        v4u o; o.x = pk2(s[0 * 33], s[1 * 33]); o.y = pk2(s[2 * 33], s[3 * 33]); o.z = pk2(s[4 * 33], s[5 * 33]); o.w = pk2(s[6 * 33], s[7 * 33]);
        *(GAS v4u*)(WT + (size_t)(drow0 + n) * K + k0 + 8 * c) = o; }
    LDS_WAIT(); asm volatile("" ::: "memory");
}
__device__ __forceinline__ void p0_prologue(Frame& F, const Args& a) {
    const int lane = pg8::pg8_lane_id(), tid = F.wave * 64 + lane; (void)tid;
    const float* c_in = a.in[1]; const float* w_ada = a.in[2]; const float* b_ada = a.in[3];
    float* MOD = (float*)(F.ws + WS_MOD);
    LAS float* sc = (LAS float*)(F.lds + RING_OFF + 96 * 1024);
    LAS float* red = (LAS float*)(F.lds + RING_OFF + 112 * 1024);
    for (int i = tid; i < NB * D; i += NWAVES * 64) { const float v = c_in[i]; sc[i] = v / (1.f + __expf(-v)); }
    __syncthreads();
    for (int item = blockIdx.x; item < 2 * (NMOD / 32); item += F.G) {
        const int l = item / (NMOD / 32), n0 = (item % (NMOD / 32)) * 32, col = lane & 31, kpar = lane >> 5;
        const float* wp = w_ada + (size_t)l * D * NMOD + n0 + col;
        float a0 = 0.f, a1 = 0.f, a2 = 0.f, a3 = 0.f;
#pragma unroll 8
        for (int i = 0; i < 64; ++i) { const int k = 128 * F.wave + 2 * i + kpar; const float wv = wp[(size_t)k * NMOD];
            a0 += sc[k] * wv; a1 += sc[D + k] * wv; a2 += sc[2 * D + k] * wv; a3 += sc[3 * D + k] * wv; }
        a0 += __shfl_xor(a0, 32); a1 += __shfl_xor(a1, 32); a2 += __shfl_xor(a2, 32); a3 += __shfl_xor(a3, 32);
        if (lane < 32) { red[(F.wave * 4 + 0) * 32 + col] = a0; red[(F.wave * 4 + 1) * 32 + col] = a1; red[(F.wave * 4 + 2) * 32 + col] = a2; red[(F.wave * 4 + 3) * 32 + col] = a3; }
        __syncthreads();
        if (tid < 128) { const int b = tid >> 5, cc = tid & 31; float s = 0.f;
#pragma unroll
            for (int w = 0; w < 8; ++w) s += red[(w * 4 + b) * 32 + cc];
            MOD[(size_t)(l * NB + b) * NMOD + n0 + cc] = s + b_ada[l * NMOD + n0 + cc]; }
        __syncthreads();
    }
    { bf16* WFT = (bf16*)(F.ws + WS_WFT); const float* w = a.in[7];
      for (int i = blockIdx.x * (NWAVES * 64) + tid; i < 16 * D; i += F.G * NWAVES * 64) { const int hh = i & 15, k = i >> 4; WFT[hh * D + k] = (bf16)f2bf(w[(size_t)k * (3 * D + 16) + 3 * D + hh]); } }
    LAS float* scr = (LAS float*)(F.lds + RING_OFF + F.wave * 8448);
    const int gw = F.vcu * NWAVES + F.wave, NGW = F.G * NWAVES;
    constexpr int I_FI = 16 * 96, I_FO = 16 * 32, I_SI = 16 * 48, I_SO = 16 * 32, I_GU = 16 * 224, I_DN = 56 * 32;
    constexpr int NITEMS = I_FI + I_FO + I_SI + I_SO + I_GU + I_DN + NE * (I_GU + I_DN);
    for (int it = gw; it < NITEMS; it += NGW) {
        int r = it;
        if (r < I_FI) { tr_item(a.in[7], 3 * D + 16, D, 96, r, (bf16*)(F.ws + WS_WFOXIN), false, scr, lane); continue; } r -= I_FI;
        if (r < I_FO) { tr_item(a.in[9], D, D, 32, r, (bf16*)(F.ws + WS_WFOXOUT), false, scr, lane); continue; } r -= I_FO;
        if (r < I_SI) { tr_item(a.in[10], D + 512, D, 48, r, (bf16*)(F.ws + WS_WSWAIN), false, scr, lane); continue; } r -= I_SI;
        if (r < I_SO) { tr_item(a.in[12], D, D, 32, r, (bf16*)(F.ws + WS_WSWAOUT), false, scr, lane); continue; } r -= I_SO;
        if (r < I_GU) { tr_item(a.in[14], 2 * FF, D, 224, r, (bf16*)(F.ws + WS_WGU), true, scr, lane); continue; } r -= I_GU;
        if (r < I_DN) { tr_item(a.in[15], D, FF, 32, r, (bf16*)(F.ws + WS_WDN), false, scr, lane); continue; } r -= I_DN;
        if (r < NE * I_GU) { const int e = r / I_GU, rr = r % I_GU; tr_item(a.in[18] + (size_t)e * D * 2 * FF, 2 * FF, D, 224, rr, (bf16*)(F.ws + WS_WMGU) + (size_t)e * 2 * FF * D, true, scr, lane); continue; } r -= NE * I_GU;
        { const int e = r / I_DN, rr = r % I_DN; tr_item(a.in[19] + (size_t)e * FF * D, D, FF, 32, rr, (bf16*)(F.ws + WS_WMDN) + (size_t)e * D * FF, false, scr, lane); }
    }
}

__device__ __forceinline__ void norm_mod_rows(Frame& F, const float* xin, const float* g, const float* shift, const float* scale, bf16* XN) {
    const int lane = pg8::pg8_lane_id(), tid = F.wave * 64 + lane; (void)tid;
    const int gw = F.vcu * NWAVES + F.wave, NGW = F.G * NWAVES;
    for (int rg = gw; rg < M / 8; rg += NGW) {
        const int row0 = rg * 8, b = row0 / S;
        f32x4 gs[4], sh[4];
#pragma unroll
        for (int j = 0; j < 4; ++j) { const f32x4 gv = ((const GAS f32x4*)g)[lane + 64 * j], sv = ((const GAS f32x4*)(scale + (size_t)b * NMOD))[lane + 64 * j];
            gs[j] = gv * (sv + 1.0f); sh[j] = ((const GAS f32x4*)(shift + (size_t)b * NMOD))[lane + 64 * j]; }
#pragma unroll 2
        for (int r = 0; r < 8; ++r) {
            const GAS f32x4* xr = (const GAS f32x4*)(xin + (size_t)(row0 + r) * D) + lane;
            f32x4 v[4]; float s = 0.f;
#pragma unroll
            for (int j = 0; j < 4; ++j) { v[j] = xr[64 * j]; s += (v[j].x * v[j].x + v[j].y * v[j].y) + (v[j].z * v[j].z + v[j].w * v[j].w); }
            const float rstd = rsqrtf(wave_sum(s) * (1.f / D) + RMS_EPS);
            GAS unsigned long long* o8 = (GAS unsigned long long*)(XN + (size_t)(row0 + r) * D) + lane;
#pragma unroll
            for (int j = 0; j < 4; ++j) { const f32x4 y = v[j] * rstd * gs[j] + sh[j];
                o8[64 * j] = (unsigned long long)pg8::cvt_pk_bf16(y.x, y.y) | ((unsigned long long)pg8::cvt_pk_bf16(y.z, y.w) << 32); }
        }
    }
}
__device__ __forceinline__ void fgate_groups(Frame& F, const bf16* XN, const bf16* WFT, const float* b_f, float* LOGFT) {
    const int lane = pg8::pg8_lane_id(), tid = F.wave * 64 + lane; (void)tid;
    const int gw = F.vcu * NWAVES + F.wave, NGW = F.G * NWAVES, fr = lane & 15, fq = lane >> 4;
    for (int grp = gw; grp < M / 16; grp += NGW) {
        const int row0 = grp * 16;
        const bf16* ap = XN + (size_t)(row0 + fr) * D + 8 * fq; const bf16* wp = WFT + (size_t)fr * D + 8 * fq;
        f32x4 acc = (f32x4){0.f, 0.f, 0.f, 0.f};
#pragma unroll 8
        for (int kk = 0; kk < 32; ++kk) { const bf16x8 xv = *(const GAS bf16x8*)(ap + 32 * kk), wv = *(const GAS bf16x8*)(wp + 32 * kk);
            acc = __builtin_amdgcn_mfma_f32_16x16x32_bf16(wv, xv, acc, 0, 0, 0); }
        const int row = row0 + fr, b = row / S, s = row % S;
#pragma unroll
        for (int r = 0; r < 4; ++r) { const int hh = 4 * fq + r; const float z = acc[r] + b_f[hh];
            const float ls = fminf(z, 0.f) - log1pf(__expf(-fabsf(z)));
            LOGFT[(size_t)(b * NH + hh) * S + s] = ls * LOG2E; }
    }
}
__device__ __forceinline__ void block_scan4096(Frame& F, const float* src, LAS float* cum, LAS float* part) {
    const int lane = pg8::pg8_lane_id(), tid = F.wave * 64 + lane; (void)tid;
    const GAS f32x4* p = (const GAS f32x4*)src + 2 * tid;
    const f32x4 a = p[0], b = p[1];
    float v[8]; v[0] = a.x; v[1] = v[0] + a.y; v[2] = v[1] + a.z; v[3] = v[2] + a.w; v[4] = v[3] + b.x; v[5] = v[4] + b.y; v[6] = v[5] + b.z; v[7] = v[6] + b.w;
    float incl = v[7];
#pragma unroll
    for (int o = 1; o < 64; o <<= 1) { const float t = __shfl_up(incl, o); if (lane >= o) incl += t; }
    if (lane == 63) part[F.wave] = incl;
    __syncthreads();
    float base = incl - v[7];
#pragma unroll
    for (int w = 0; w < 8; ++w) if (w < F.wave) base += part[w];
#pragma unroll
    for (int i = 0; i < 8; ++i) cum[8 * tid + i] = v[i] + base;
    __syncthreads();
}
__device__ __forceinline__ void simple_attn_row_init(const bf16* qrow, unsigned (&q2)[32]) {
#pragma unroll
    for (int i = 0; i < 8; ++i) { const v4u t = *(const GAS v4u*)(qrow + 8 * i); q2[4 * i] = t.x; q2[4 * i + 1] = t.y; q2[4 * i + 2] = t.z; q2[4 * i + 3] = t.w; }
}
__device__ __forceinline__ void simple_kv_tile_load(const bf16* kbase, const bf16* vbase, size_t pitch, LAS unsigned char* reg, int lane) {
    const int key = lane >> 1, half = lane & 1;
#pragma unroll
    for (int i = 0; i < 4; ++i) { *(LAS v4u*)(reg + key * 128 + half * 64 + 16 * i) = *(const GAS v4u*)(kbase + (size_t)key * pitch + half * 32 + 8 * i);
        *(LAS v4u*)(reg + 4096 + key * 128 + half * 64 + 16 * i) = *(const GAS v4u*)(vbase + (size_t)key * pitch + half * 32 + 8 * i); }
    LDS_WAIT(); __builtin_amdgcn_wave_barrier(); asm volatile("" ::: "memory");
}
__device__ __forceinline__ float simple_dot(const unsigned (&q2)[32], const LAS unsigned char* krow) {
    float s = 0.f;
#pragma unroll
    for (int i = 0; i < 8; ++i) { const v4u t = *(const LAS v4u*)(krow + 16 * i);
        s += bf_lo(q2[4 * i]) * bf_lo(t.x) + bf_hi(q2[4 * i]) * bf_hi(t.x); s += bf_lo(q2[4 * i + 1]) * bf_lo(t.y) + bf_hi(q2[4 * i + 1]) * bf_hi(t.y);
        s += bf_lo(q2[4 * i + 2]) * bf_lo(t.z) + bf_hi(q2[4 * i + 2]) * bf_hi(t.z); s += bf_lo(q2[4 * i + 3]) * bf_lo(t.w) + bf_hi(q2[4 * i + 3]) * bf_hi(t.w); }
    return s;
}
__device__ __forceinline__ void simple_pv(float (&acc)[64], float al, float p, const LAS unsigned char* vrow) {
#pragma unroll
    for (int i = 0; i < 8; ++i) { const v4u t = *(const LAS v4u*)(vrow + 16 * i);
        acc[8 * i + 0] = acc[8 * i + 0] * al + p * bf_lo(t.x); acc[8 * i + 1] = acc[8 * i + 1] * al + p * bf_hi(t.x);
        acc[8 * i + 2] = acc[8 * i + 2] * al + p * bf_lo(t.y); acc[8 * i + 3] = acc[8 * i + 3] * al + p * bf_hi(t.y);
        acc[8 * i + 4] = acc[8 * i + 4] * al + p * bf_lo(t.z); acc[8 * i + 5] = acc[8 * i + 5] * al + p * bf_hi(t.z);
        acc[8 * i + 6] = acc[8 * i + 6] * al + p * bf_lo(t.w); acc[8 * i + 7] = acc[8 * i + 7] * al + p * bf_hi(t.w); }
}
__device__ __forceinline__ void simple_store_row(bf16* orow, const float (&acc)[64], float inv) {
#pragma unroll
    for (int i = 0; i < 8; ++i) { v4u t; t.x = pg8::cvt_pk_bf16(acc[8 * i] * inv, acc[8 * i + 1] * inv); t.y = pg8::cvt_pk_bf16(acc[8 * i + 2] * inv, acc[8 * i + 3] * inv);
        t.z = pg8::cvt_pk_bf16(acc[8 * i + 4] * inv, acc[8 * i + 5] * inv); t.w = pg8::cvt_pk_bf16(acc[8 * i + 6] * inv, acc[8 * i + 7] * inv); *(GAS v4u*)(orow + 8 * i) = t; }
}
__device__ __forceinline__ void fox_attn_simple(Frame& F, const bf16* Q, const bf16* K, const bf16* V, bf16* O, const float* LOGFT) {
    const int lane = pg8::pg8_lane_id(), tid = F.wave * 64 + lane; (void)tid;
    LAS float* cum = (LAS float*)(F.lds + RING_OFF + 65536); LAS float* part = (LAS float*)(F.lds + RING_OFF + 65536 + 16384);
    LAS unsigned char* reg = F.lds + RING_OFF + F.wave * 8192;
    for (int pb = F.vcu; pb < 256; pb += F.G) {
        const int bh = pb >> 2, b = bh / NH, h = bh % NH;
        block_scan4096(F, LOGFT + (size_t)bh * S, cum, part);
        const int j = (pb * 8 + F.wave) & 31;
        for (int which = 0; which < 2; ++which) {
            const int qt = which ? 63 - j : j, row = qt * 64 + lane;
            unsigned q2[32]; simple_attn_row_init(Q + (size_t)(b * S + row) * D + h * 64, q2);
            float acc[64];
#pragma unroll
            for (int d = 0; d < 64; ++d) acc[d] = 0.f;
            float m = -INFINITY, l = 0.f; const float cq = cum[row];
            for (int kt = 0; kt < 2 * qt + 2; ++kt) {
                __builtin_amdgcn_wave_barrier(); asm volatile("" ::: "memory");
                simple_kv_tile_load(K + (size_t)(b * S + kt * 32) * D + h * 64, V + (size_t)(b * S + kt * 32) * D + h * 64, D, reg, lane);
                for (int jj = 0; jj < 32; ++jj) { const int key = kt * 32 + jj;
                    const float s = simple_dot(q2, reg + jj * 128) + cq - cum[key];
                    if (key <= row) { const float mn = fmaxf(m, s), al = __builtin_amdgcn_exp2f(m - mn), p = __builtin_amdgcn_exp2f(s - mn); l = l * al + p; m = mn; simple_pv(acc, al, p, reg + 4096 + jj * 128); } }
            }
            simple_store_row(O + (size_t)(b * S + row) * D + h * 64, acc, 1.f / l);
        }
        __syncthreads();
    }
}
__device__ __forceinline__ int t5_bucket(int rel) {
    const int n = rel < 0 ? -rel : rel;
    const int v = n < 8 ? n : 8 + (n >= 12) + (n >= 16) + (n >= 23) + (n >= 32) + (n >= 46) + (n >= 64) + (n >= 91);
    return (rel > 0 ? 16 : 0) + v;
}
__device__ __forceinline__ void swa_attn_simple(Frame& F, const bf16* Q, const bf16* K, const bf16* V, bf16* O, const float* sinks, const float* rel_bias) {
    const int lane = pg8::pg8_lane_id(), tid = F.wave * 64 + lane; (void)tid;
    LAS unsigned char* reg = F.lds + RING_OFF + F.wave * 8192;
    LAS float* T = (LAS float*)(F.lds + RING_OFF + 65536 + F.wave * 1024);
    const int gw = F.vcu * NWAVES + F.wave, NGW = F.G * NWAVES;
    for (int ui = gw; ui < NB * 64 * NH; ui += NGW) {
        const int hq = ui % NH, c = (ui / NH) % 64, b = ui / (NH * 64), hk = hq >> 2, row = c * 64 + lane;
        __builtin_amdgcn_wave_barrier(); asm volatile("" ::: "memory");
        for (int i = lane; i < 255; i += 64) T[i] = rel_bias[t5_bucket(i - 191) * NH + hq] * LOG2E;
        unsigned q2[32]; simple_attn_row_init(Q + (size_t)(b * S + row) * D + hq * 64, q2);
        float acc[64];
#pragma unroll
        for (int d = 0; d < 64; ++d) acc[d] = 0.f;
        float m = -INFINITY, l = 0.f;
        for (int kt = 0; kt < 6; ++kt) {
            const int pos0 = 64 * c - 128 + 32 * kt; if (pos0 < 0) continue;
            __builtin_amdgcn_wave_barrier(); asm volatile("" ::: "memory");
            simple_kv_tile_load(K + (size_t)(b * S + pos0) * 256 + hk * 64, V + (size_t)(b * S + pos0) * 256 + hk * 64, 256, reg, lane);
            for (int jj = 0; jj < 32; ++jj) { const int kb = 32 * kt + jj;
                const float s = simple_dot(q2, reg + jj * 128) + T[kb + 63 - lane];
                const float mn = fmaxf(m, s), al = __builtin_amdgcn_exp2f(m - mn), p = __builtin_amdgcn_exp2f(s - mn); l = l * al + p; m = mn; simple_pv(acc, al, p, reg + 4096 + jj * 128); }
        }
        const float sk = sinks[hq] * LOG2E, mf = fmaxf(m, sk), al = __builtin_amdgcn_exp2f(m - mf);
        l = l * al + __builtin_amdgcn_exp2f(sk - mf);
        simple_store_row(O + (size_t)(b * S + row) * D + hq * 64, acc, al / l);
    }
}
__device__ __forceinline__ void route_rows(Frame& F, const float* xin, const float* g, const float* shift, const float* scale, const float* w_router, const float* b_router,
                                           bf16* XS, int* list, float* wl, gu32* cnt) {
    const int lane = pg8::pg8_lane_id(), tid = F.wave * 64 + lane; (void)tid;
    LAS float* wr = (LAS float*)(F.lds + RING_OFF);
    volatile LAS int* rt = (volatile LAS int*)(F.lds + RT_OFF);
    for (int i = tid; i < D * NE; i += NWAVES * 64) wr[i] = w_router[i];
    for (int blk = F.vcu; blk < M / 32; blk += F.G) {
        if (tid < 16) rt[tid] = 0;
        __syncthreads();
        const int row0 = blk * 32 + F.wave * 4, b = row0 / S;
        f32x4 gs[4], sh[4];
#pragma unroll
        for (int j = 0; j < 4; ++j) { const f32x4 gv = ((const GAS f32x4*)g)[lane + 64 * j], sv = ((const GAS f32x4*)(scale + (size_t)b * NMOD))[lane + 64 * j];
            gs[j] = gv * (sv + 1.0f); sh[j] = ((const GAS f32x4*)(shift + (size_t)b * NMOD))[lane + 64 * j]; }
        unsigned hp[4][8]; int e0[4], e1[4], p0[4], p1[4]; float w0[4];
#pragma unroll
        for (int r = 0; r < 4; ++r) {
            const GAS f32x4* xr = (const GAS f32x4*)(xin + (size_t)(row0 + r) * D) + lane;
            f32x4 v[4]; float s = 0.f;
#pragma unroll
            for (int j = 0; j < 4; ++j) { v[j] = xr[64 * j]; s += (v[j].x * v[j].x + v[j].y * v[j].y) + (v[j].z * v[j].z + v[j].w * v[j].w); }
            const float rstd = rsqrtf(wave_sum(s) * (1.f / D) + RMS_EPS);
            float lg[8];
#pragma unroll
            for (int e = 0; e < 8; ++e) lg[e] = 0.f;
#pragma unroll
            for (int j = 0; j < 4; ++j) { const f32x4 y = v[j] * rstd * gs[j] + sh[j];
                hp[r][2 * j] = pg8::cvt_pk_bf16(y.x, y.y); hp[r][2 * j + 1] = pg8::cvt_pk_bf16(y.z, y.w);
#pragma unroll
                for (int i = 0; i < 4; ++i) { const LAS f32x4* wq = (const LAS f32x4*)(wr + (size_t)(4 * lane + 256 * j + i) * 8); const f32x4 wa = wq[0], wb = wq[1]; const float yv = y[i];
                    lg[0] += yv * wa.x; lg[1] += yv * wa.y; lg[2] += yv * wa.z; lg[3] += yv * wa.w; lg[4] += yv * wb.x; lg[5] += yv * wb.y; lg[6] += yv * wb.z; lg[7] += yv * wb.w; } }
#pragma unroll
            for (int e = 0; e < 8; ++e) lg[e] = wave_sum(lg[e]) + b_router[e];
            int i0 = 0; float v0 = lg[0];
#pragma unroll
            for (int e = 1; e < 8; ++e) if (lg[e] > v0) { v0 = lg[e]; i0 = e; }
            int i1 = 0; float v1 = -INFINITY;
#pragma unroll
            for (int e = 0; e < 8; ++e) if (e != i0 && lg[e] > v1) { v1 = lg[e]; i1 = e; }
            const float wt1 = 1.f / (1.f + __expf(v0 - v1));
            e0[r] = i0; e1[r] = i1; w0[r] = 1.f - wt1;
            int q0 = 0, q1 = 0;
            if (lane == 0) { q0 = __hip_atomic_fetch_add((LAS int*)rt + i0, 1, __ATOMIC_RELAXED, __HIP_MEMORY_SCOPE_WORKGROUP); q1 = __hip_atomic_fetch_add((LAS int*)rt + i1, 1, __ATOMIC_RELAXED, __HIP_MEMORY_SCOPE_WORKGROUP); }
            p0[r] = __builtin_amdgcn_readfirstlane(q0); p1[r] = __builtin_amdgcn_readfirstlane(q1);
        }
        __syncthreads();
        if (tid < 8) rt[8 + tid] = (int)__hip_atomic_fetch_add(cnt + 64 * tid, (unsigned)rt[tid], __ATOMIC_RELAXED, __HIP_MEMORY_SCOPE_AGENT);
        __syncthreads();
#pragma unroll
        for (int r = 0; r < 4; ++r) {
            const int tok = row0 + r;
            const int d0 = e0[r] * ECAP + rt[8 + e0[r]] + p0[r], d1 = e1[r] * ECAP + rt[8 + e1[r]] + p1[r];
            GAS unsigned long long* o0 = (GAS unsigned long long*)(XS + (size_t)d0 * D) + lane; GAS unsigned long long* o1 = (GAS unsigned long long*)(XS + (size_t)d1 * D) + lane;
#pragma unroll
            for (int j = 0; j < 4; ++j) { const unsigned long long pk = (unsigned long long)hp[r][2 * j] | ((unsigned long long)hp[r][2 * j + 1] << 32); o0[64 * j] = pk; o1[64 * j] = pk; }
            if (lane == 0) { list[d0] = 2 * tok; wl[d0] = w0[r]; list[d1] = 2 * tok + 1; wl[d1] = 1.f - w0[r]; }
        }
        __syncthreads();
    }
}
__device__ __forceinline__ void final_rows(Frame& F, const float* XA, const bf16* YS, const float* gate, const float* g, float* out) {
    const int lane = pg8::pg8_lane_id(), tid = F.wave * 64 + lane; (void)tid;
    const int gw = F.vcu * NWAVES + F.wave, NGW = F.G * NWAVES;
    for (int rg = gw; rg < M / 8; rg += NGW) {
        const int row0 = rg * 8, b = row0 / S;
        f32x4 gt[4], gf[4];
#pragma unroll
        for (int j = 0; j < 4; ++j) { gt[j] = ((const GAS f32x4*)(gate + (size_t)b * NMOD))[lane + 64 * j]; gf[j] = ((const GAS f32x4*)g)[lane + 64 * j]; }
#pragma unroll 2
        for (int r = 0; r < 8; ++r) {
            const int row = row0 + r;
            const GAS f32x4* xr = (const GAS f32x4*)(XA + (size_t)row * D) + lane;
            const GAS unsigned long long* y0 = (const GAS unsigned long long*)(YS + (size_t)(2 * row) * D) + lane; const GAS unsigned long long* y1 = (const GAS unsigned long long*)(YS + (size_t)(2 * row + 1) * D) + lane;
            f32x4 v[4]; float s = 0.f;
#pragma unroll
            for (int j = 0; j < 4; ++j) { const unsigned long long a = y0[64 * j], c = y1[64 * j]; const unsigned al = (unsigned)a, ah = (unsigned)(a >> 32), cl = (unsigned)c, ch = (unsigned)(c >> 32);
                const f32x4 ys = (f32x4){bf_lo(al) + bf_lo(cl), bf_hi(al) + bf_hi(cl), bf_lo(ah) + bf_lo(ch), bf_hi(ah) + bf_hi(ch)};
                v[j] = xr[64 * j] + gt[j] * ys; s += (v[j].x * v[j].x + v[j].y * v[j].y) + (v[j].z * v[j].z + v[j].w * v[j].w); }
            const float rstd = rsqrtf(wave_sum(s) * (1.f / D) + RMS_EPS);
            GAS f32x4* o = (GAS f32x4*)(out + (size_t)row * D) + lane;
#pragma unroll
            for (int j = 0; j < 4; ++j) o[64 * j] = v[j] * rstd * gf[j];
        }
    }
}

__global__ void __launch_bounds__(NWAVES * 64, 2) mk_fwd(Args args) {
    extern __shared__ __attribute__((aligned(16))) unsigned char lds[];
    Frame F;
    F.lds = (LAS unsigned char*)lds;
    F.MISC = (volatile LAS unsigned*)(F.lds + MISC_OFF);
    F.wave = __builtin_amdgcn_readfirstlane((int)threadIdx.x >> 6);
    F.G = gridDim.x; { const int bx = blockIdx.x; F.vcu = (F.G % 8 == 0) ? (bx % 8) * (F.G / 8) + bx / 8 : bx; }
    F.ws = args.ws; F.ctl = (gu32*)(args.ws + WS_CTL);
    for (int u = F.wave * 64 + pg8::pg8_lane_id(); u < (LDS_BYTES - LDSCTL_OFF) / 4; u += NWAVES * 64) ((LAS unsigned*)(F.lds + LDSCTL_OFF))[u] = 0u;
    __syncthreads();
    XcdBarrier bar = xcd_barrier_post((unsigned*)(F.ctl + CW_BAR), F.MISC + 8, F.wave == 0 && pg8::pg8_lane_id() == 0);
    const int lo = args.ph_lo, hi = args.ph_hi;
#define IN(k) (lo <= (k) && (k) < hi)
#define SEAM(k) do { if (IN(k) && IN((k) + 1)) xcd_barrier(bar, F.wave == 0 && pg8::pg8_lane_id() == 0); } while (0)
    unsigned char* ws = args.ws;
    const float* MOD0 = (const float*)(ws + WS_MOD); const float* MOD1 = MOD0 + NB * NMOD;
    bf16* XN = (bf16*)(ws + WS_XN); bf16* QO = (bf16*)(ws + WS_QO); bf16* KB = (bf16*)(ws + WS_K); bf16* VB = (bf16*)(ws + WS_V);
    float* XA = (float*)(ws + WS_XA); bf16* ACT = (bf16*)(ws + WS_ACT); bf16* XS = (bf16*)(ws + WS_XS); bf16* ACT2 = (bf16*)(ws + WS_ACT2); bf16* YS = (bf16*)(ws + WS_YS);
    float* LOGFT = (float*)(ws + WS_LOGFT);

    if (IN(0)) { p0_prologue(F, args); } SEAM(0);
    if (IN(1)) { norm_mod_rows(F, args.in[0], args.in[4], MOD0 + 0 * D, MOD0 + 1 * D, XN); } SEAM(1);
    if (IN(2)) {
        fgate_groups(F, XN, (const bf16*)(ws + WS_WFT), args.in[8], LOGFT);
        pg8::Gemm g{XN, (const pg8::bf16_t*)(ws + WS_WFOXIN), M, 3 * D, D}; pg8::StaticOrder So; So.init(M, 3 * D, F.G, (int)blockIdx.x);
        pg8::EpiQKV<0> E{QO, (size_t)(WS_K - WS_QO) / 2, C2};
        pg8::gemm_phase<pg8::EpiQKV<0>, pg8::StaticOrder, true, true>(F.lds + RING_OFF, g, So, E, F.wave);
    } SEAM(2);
    if (IN(3)) {
        static_assert(attn_body::ATTN_LDS_BYTES <= 96 * 1024, "attention scratch vs the cumulative-gate table");
        const attn_body::AttnTensors AT{(const attn_body::bf16*)QO, (const attn_body::bf16*)KB, (const attn_body::bf16*)VB, (attn_body::bf16*)QO};
        attn_body::attn_phase((char*)lds + RING_OFF, AT, LOGFT, (LAS float*)(F.lds + RING_OFF + 96 * 1024), (LAS float*)(F.lds + RING_OFF + 112 * 1024), F.vcu, F.G, F.wave);
    } SEAM(3);
    if (IN(4)) {
        pg8::Gemm g{QO, (const pg8::bf16_t*)(ws + WS_WFOXOUT), M, D, D}; pg8::StaticOrder So; So.init(M, D, F.G, (int)blockIdx.x);
        pg8::EpiResid E{args.in[0], XA, MOD0 + 2 * D, D, S, NMOD};
        pg8::gemm_phase<pg8::EpiResid, pg8::StaticOrder, true, true>(F.lds + RING_OFF, g, So, E, F.wave);
    } SEAM(4);
    if (IN(5)) { norm_mod_rows(F, XA, args.in[5], MOD0 + 3 * D, MOD0 + 4 * D, XN); } SEAM(5);
    if (IN(6)) {
        pg8::Gemm g{XN, (const pg8::bf16_t*)(ws + WS_WGU), M, 2 * FF, D}; pg8::StaticOrder So; So.init(M, 2 * FF, F.G, (int)blockIdx.x);
        pg8::EpiSwiglu E{ACT, FF};
        pg8::gemm_phase<pg8::EpiSwiglu, pg8::StaticOrder, true, true>(F.lds + RING_OFF, g, So, E, F.wave);
    } SEAM(6);
    if (IN(7)) {
        pg8::Gemm g{ACT, (const pg8::bf16_t*)(ws + WS_WDN), M, D, FF}; pg8::StaticOrder So; So.init(M, D, F.G, (int)blockIdx.x);
        pg8::EpiResid E{XA, XA, MOD0 + 5 * D, D, S, NMOD};
        pg8::gemm_phase<pg8::EpiResid, pg8::StaticOrder, true, true>(F.lds + RING_OFF, g, So, E, F.wave);
    } SEAM(7);
    if (IN(8)) { norm_mod_rows(F, XA, args.in[4] + D, MOD1 + 0 * D, MOD1 + 1 * D, XN); } SEAM(8);
    if (IN(9)) {
        pg8::Gemm g{XN, (const pg8::bf16_t*)(ws + WS_WSWAIN), M, D + 512, D}; pg8::StaticOrder So; So.init(M, D + 512, F.G, (int)blockIdx.x);
        pg8::EpiQKV<1> E{QO, (size_t)(WS_K - WS_QO) / 2, C2};
        pg8::gemm_phase<pg8::EpiQKV<1>, pg8::StaticOrder, true, true>(F.lds + RING_OFF, g, So, E, F.wave);
    } SEAM(9);
    if (IN(10)) { swa_attn_simple(F, QO, KB, VB, QO, args.in[11], args.in[13]); } SEAM(10);
    if (IN(11)) {
        pg8::Gemm g{QO, (const pg8::bf16_t*)(ws + WS_WSWAOUT), M, D, D}; pg8::StaticOrder So; So.init(M, D, F.G, (int)blockIdx.x);
        pg8::EpiResid E{XA, XA, MOD1 + 2 * D, D, S, NMOD};
        pg8::gemm_phase<pg8::EpiResid, pg8::StaticOrder, true, true>(F.lds + RING_OFF, g, So, E, F.wave);
    } SEAM(11);
    if (IN(12)) { route_rows(F, XA, args.in[5] + D, MOD1 + 3 * D, MOD1 + 4 * D, args.in[16], args.in[17], XS, (int*)(ws + WS_LIST), (float*)(ws + WS_WL), F.ctl + CW_CNT); } SEAM(12);
    if (IN(13) || IN(14)) {
        volatile LAS int* tab = (volatile LAS int*)(F.lds + TAB_OFF);
        if (F.wave == 0 && pg8::pg8_lane_id() == 0) { int accp = 0;
            for (int e = 0; e < NE; ++e) { const int n = (int)__hip_atomic_load(F.ctl + CW_CNT + 64 * e, RLX_AGENT); tab[e] = accp; accp += (n + 255) >> 8; }
            tab[8] = accp; }
        __syncthreads();
    }
    if (IN(13)) {
        pg8::Gemm g{XS, (const pg8::bf16_t*)(ws + WS_WMGU), M, 2 * FF, D}; pg8::MoeOrder So; So.init((const LAS int*)(F.lds + TAB_OFF), 2 * FF / 256, F.G, (int)blockIdx.x, ECAP / 256);
        pg8::EpiSwiglu E{ACT2, FF};
        pg8::gemm_phase<pg8::EpiSwiglu, pg8::MoeOrder, true, true>(F.lds + RING_OFF, g, So, E, F.wave);
    } SEAM(13);
    if (IN(14)) {
        pg8::Gemm g{ACT2, (const pg8::bf16_t*)(ws + WS_WMDN), M, D, FF}; pg8::MoeOrder So; So.init((const LAS int*)(F.lds + TAB_OFF), D / 256, F.G, (int)blockIdx.x, 0);
        pg8::EpiScatter E{YS, (const int*)(ws + WS_LIST), (const float*)(ws + WS_WL), (const unsigned*)(F.ctl + CW_CNT), ECAP, 64};
        pg8::gemm_phase<pg8::EpiScatter, pg8::MoeOrder, true, true>(F.lds + RING_OFF, g, So, E, F.wave);
    } SEAM(14);
    if (IN(15)) { final_rows(F, XA, YS, MOD1 + 5 * D, args.in[6], args.out); }
#undef IN
#undef SEAM
}

extern "C" void kernel_launch(void* const* d_in, const int* in_sizes, int n_in, void* d_out, int out_size, void* d_ws, size_t ws_size, hipStream_t stream) {
    static int grid = 0;
    if (grid == 0) {
        if (n_in != 20 || out_size != M * D || ws_size < WS_END) { fprintf(stderr, "kernel_launch: unexpected problem (n_in %d, out %d, ws %zu)\n", n_in, out_size, ws_size); grid = -1; return; }
        int dev = 0, cus = 0, per_cu = 0;
        if (hipGetDevice(&dev) != hipSuccess || hipDeviceGetAttribute(&cus, hipDeviceAttributeMultiprocessorCount, dev) != hipSuccess) { grid = -1; return; }
        if (hipFuncSetAttribute((const void*)mk_fwd, hipFuncAttributeMaxDynamicSharedMemorySize, LDS_BYTES) != hipSuccess) { fprintf(stderr, "kernel_launch: hipFuncSetAttribute failed\n"); grid = -1; return; }
        if (hipOccupancyMaxActiveBlocksPerMultiprocessor(&per_cu, (const void*)mk_fwd, NWAVES * 64, LDS_BYTES) != hipSuccess || per_cu < 1) { fprintf(stderr, "kernel_launch: occupancy query reports %d\n", per_cu); (void)hipGetLastError(); grid = -1; return; }
        grid = cus;
    }
    if (grid < 0) return;
    if (hipMemsetAsync((char*)d_ws + WS_CTL, 0, CTL_ZERO_BYTES, stream) != hipSuccess) return;
    Args a{};
    for (int i = 0; i < 20; ++i) a.in[i] = (const float*)d_in[i];
    a.out = (float*)d_out; a.ws = (unsigned char*)d_ws; a.ph_lo = 0; a.ph_hi = 16;
    hipLaunchKernelGGL(mk_fwd, dim3(grid), dim3(NWAVES * 64), LDS_BYTES, stream, a);
}
```

```cpp
#include <hip/hip_runtime.h>
#include <cstdio>
#include <cstdint>
#include <cmath>
namespace pg8 {
#define PG8_LAS __attribute__((address_space(3)))
typedef unsigned short bf16_t;
typedef short bf16x8 __attribute__((ext_vector_type(8)));
typedef float f32x4 __attribute__((ext_vector_type(4)));
typedef unsigned u32x4 __attribute__((ext_vector_type(4)));
constexpr int BM = 256, BK = 64, HALF = 128, HTB = HALF * BK * 2  , STAGE_BYTES = 8 * HTB, NXCD = 8, WGM = 8;

__host__ __device__ __forceinline__ int lds_byte(int r, int c) { const int st = (r >> 4) * 2 + (c >> 5), rr = r & 15, cc = c & 31, ob = rr * 64 + cc * 2; return st * 1024 + (ob ^ (((ob >> 9) & 1) << 5)); }
__host__ __device__ __forceinline__ void stage_rc(int b, int& R, int& C) { const int st = b / 1024, sb = b % 1024, swz = sb ^ (((sb >> 9) & 1) << 5); R = (st >> 1) * 16 + swz / 64; C = (st & 1) * 32 + (swz % 64) / 2; }
__host__ __device__ __forceinline__ int perm32(int rho) { const int n = rho >> 4, i = rho & 15; return 8 * (i >> 2) + 4 * n + (i & 3); }
__device__ __forceinline__ int pg8_lane_id() { int l; asm volatile("v_mbcnt_lo_u32_b32 %0, -1, 0\n\tv_mbcnt_hi_u32_b32 %0, -1, %0" : "=v"(l)); return l; }
struct Unit { int pm, pn, orow, ocol, aux, mt; };
struct Gemm { const bf16_t* A; const bf16_t* Bt; int M, N, K; };

struct StaticOrder {
    int nM, nN, nwg, G, c;
    __device__ __forceinline__ void init(int M, int N, int G_, int c_) { nM = M / BM; nN = N / BM; nwg = nM * nN; G = G_; c = c_; }
    __device__ __forceinline__ bool next(int i, Unit& u) const {
        const long L = (long)i * G + c; if (L >= nwg) return false;
        int wgid = (int)L; { const int q = nwg / NXCD, r = nwg % NXCD, xcd = wgid % NXCD, off = wgid / NXCD; wgid = (xcd < r ? xcd * (q + 1) : r * (q + 1) + (xcd - r) * q) + off; }
        const int nig = WGM * nN, gid = wgid / nig, fm = gid * WGM, gsz = (nM - fm) < WGM ? (nM - fm) : WGM;
        u.pm = fm + ((wgid % nig) % gsz); u.pn = (wgid % nig) / gsz; u.orow = u.pm * BM; u.ocol = u.pn; u.aux = 0; u.mt = u.pm; return true;
    }
    __device__ __forceinline__ void a_ready(const Unit&) const {}
    __device__ __forceinline__ void done(const Unit&) const {}
};
struct MoeOrder {
    const PG8_LAS int* tab; int nN, G, c, TM, apt;
    __device__ __forceinline__ void init(const PG8_LAS int* tab_, int nN_, int G_, int c_, int apt_) { tab = tab_; nN = nN_; G = G_; c = c_; apt = apt_; TM = __builtin_amdgcn_readfirstlane(tab_[8]); }
    __device__ __forceinline__ bool next(int i, Unit& u) const {
        const int nwg = TM * nN; const long L = (long)i * G + c; if (L >= nwg) return false;
        int wgid = (int)L; { const int q = nwg / NXCD, r = nwg % NXCD, xcd = wgid % NXCD, off = wgid / NXCD; wgid = (xcd < r ? xcd * (q + 1) : r * (q + 1) + (xcd - r) * q) + off; }
        const int nig = WGM * nN, gid = wgid / nig, fm = gid * WGM, gsz = (TM - fm) < WGM ? (TM - fm) : WGM;
        const int gm = fm + ((wgid % nig) % gsz), pnl = (wgid % nig) / gsz;
        int e = 0;
#pragma unroll
        for (int j = 1; j < 8; ++j) e += (gm >= tab[j]) ? 1 : 0;
        e = __builtin_amdgcn_readfirstlane(e);
        const int t0 = __builtin_amdgcn_readfirstlane(tab[e]), mt = gm - t0;
        u.pm = apt ? e * apt + mt : t0 + mt; u.pn = e * nN + pnl; u.orow = (t0 + mt) * BM; u.ocol = pnl; u.aux = e; u.mt = mt; return true;
    }
    __device__ __forceinline__ void a_ready(const Unit&) const {}
    __device__ __forceinline__ void done(const Unit&) const {}
};

__device__ __forceinline__ unsigned cvt_pk_bf16(float lo, float hi) { unsigned r; asm volatile("v_cvt_pk_bf16_f32 %0, %1, %2" : "=v"(r) : "v"(lo), "v"(hi)); return r; }
__device__ __forceinline__ float silu_f(float v) { return v * __builtin_amdgcn_rcpf(1.0f + __builtin_amdgcn_exp2f(-1.4426950408889634f * v)); }

template <int MODE> struct EpiQKV {
    static constexpr bool PERM = true, AFTER_DRAIN = false;
    bf16_t* Q; size_t stride; float scale0;
    __device__ __forceinline__ void operator()(const f32x4 (&acc)[2][2][4][2], const Unit& u, int wr, int wc, int fr, int fq) const {
        const int pn = u.ocol; int t, ldc, colt;
        if (MODE == 0) { t = pn >> 2; ldc = 1024; colt = (pn & 3) * 256; }
        else { if (pn < 4) { t = 0; ldc = 1024; colt = pn * 256; } else { t = pn - 3; ldc = 256; colt = 0; } }
        bf16_t* base = Q + (size_t)t * stride; const float sc = (t == 0) ? scale0 : 1.f;
        const int row0 = u.orow + wr * 64 + fr, col0 = colt + wc * 32 + 8 * fq;
#pragma unroll
        for (int ai = 0; ai < 2; ++ai)
#pragma unroll
            for (int m = 0; m < 4; ++m) { bf16_t* rowp = base + (size_t)(row0 + ai * HALF + m * 16) * ldc + col0;
#pragma unroll
                for (int bj = 0; bj < 2; ++bj) { const f32x4 v0 = acc[ai][bj][m][0] * sc, v1 = acc[ai][bj][m][1] * sc;
                    u32x4 w; w.x = cvt_pk_bf16(v0[0], v0[1]); w.y = cvt_pk_bf16(v0[2], v0[3]); w.z = cvt_pk_bf16(v1[0], v1[1]); w.w = cvt_pk_bf16(v1[2], v1[3]);
                    *(u32x4*)(rowp + bj * HALF) = w; } }
    }
};
struct EpiResid {
    static constexpr bool PERM = false, AFTER_DRAIN = false;
    const float* xin; float* out; const float* gate; int ldc, rows_per_batch, gld;
    __device__ __forceinline__ void operator()(const f32x4 (&acc)[2][2][4][2], const Unit& u, int wr, int wc, int fr, int fq) const {
        const int row0 = u.orow + wr * 64 + fr, col0 = u.ocol * BM + wc * 32 + 4 * fq;
        const float* gp = gate + (size_t)(u.orow / rows_per_batch) * gld + col0;
        f32x4 gv[2][2];
#pragma unroll
        for (int bj = 0; bj < 2; ++bj)
#pragma unroll
            for (int n = 0; n < 2; ++n) gv[bj][n] = *(const f32x4*)(gp + bj * HALF + n * 16);
#pragma unroll
        for (int ai = 0; ai < 2; ++ai)
#pragma unroll
            for (int m = 0; m < 4; ++m) { const size_t off = (size_t)(row0 + ai * HALF + m * 16) * ldc + col0;
#pragma unroll
                for (int bj = 0; bj < 2; ++bj)
#pragma unroll
                    for (int n = 0; n < 2; ++n) { const f32x4 xv = *(const f32x4*)(xin + off + bj * HALF + n * 16); *(f32x4*)(out + off + bj * HALF + n * 16) = xv + gv[bj][n] * acc[ai][bj][m][n]; }
                asm volatile("" ::: "memory"); }
    }
};
struct EpiSwiglu {
    static constexpr bool PERM = true, AFTER_DRAIN = false;
    bf16_t* O; int ldc;
    __device__ __forceinline__ void operator()(const f32x4 (&acc)[2][2][4][2], const Unit& u, int wr, int wc, int fr, int fq) const {
        const int row0 = u.orow + wr * 64 + fr, col0 = u.ocol * HALF + wc * 32 + 8 * fq;
#pragma unroll
        for (int ai = 0; ai < 2; ++ai)
#pragma unroll
            for (int m = 0; m < 4; ++m) { bf16_t* rowp = O + (size_t)(row0 + ai * HALF + m * 16) * ldc + col0;
                const f32x4 g0 = acc[ai][0][m][0], g1 = acc[ai][0][m][1], u0 = acc[ai][1][m][0], u1 = acc[ai][1][m][1];
                u32x4 w; w.x = cvt_pk_bf16(silu_f(g0[0]) * u0[0], silu_f(g0[1]) * u0[1]); w.y = cvt_pk_bf16(silu_f(g0[2]) * u0[2], silu_f(g0[3]) * u0[3]);
                w.z = cvt_pk_bf16(silu_f(g1[0]) * u1[0], silu_f(g1[1]) * u1[1]); w.w = cvt_pk_bf16(silu_f(g1[2]) * u1[2], silu_f(g1[3]) * u1[3]);
                *(u32x4*)rowp = w; }
    }
};
struct EpiScatter {
    static constexpr bool PERM = true, AFTER_DRAIN = false;
    bf16_t* YS; const int* list; const float* wl; const unsigned* cnt; int lpitch, cstride;
    __device__ __forceinline__ void operator()(const f32x4 (&acc)[2][2][4][2], const Unit& u, int wr, int wc, int fr, int fq) const {
        const int e = u.aux, ne = (int)cnt[e * cstride], p0 = u.mt * BM + wr * 64 + fr, col0 = u.ocol * BM + wc * 32 + 8 * fq;
#pragma unroll
        for (int ai = 0; ai < 2; ++ai)
#pragma unroll
            for (int m = 0; m < 4; ++m) { const int p = p0 + ai * HALF + m * 16;
                if (p < ne) { const int t2 = list[e * lpitch + p]; const float w = wl[e * lpitch + p]; bf16_t* rowp = YS + (size_t)t2 * 1024 + col0;
#pragma unroll
                    for (int bj = 0; bj < 2; ++bj) { const f32x4 v0 = acc[ai][bj][m][0] * w, v1 = acc[ai][bj][m][1] * w;
                        u32x4 q; q.x = cvt_pk_bf16(v0[0], v0[1]); q.y = cvt_pk_bf16(v0[2], v0[3]); q.z = cvt_pk_bf16(v1[0], v1[1]); q.w = cvt_pk_bf16(v1[2], v1[3]);
                        *(u32x4*)(rowp + bj * HALF) = q; } } }
    }
};

template <class Epi, class Sched, bool ALIGN_EPI = false, bool SP2 = false>
__device__ __forceinline__ void gemm_phase(PG8_LAS unsigned char* lds, const Gemm g, const Sched& S, const Epi& E, const int wid) {
    const int lane = pg8_lane_id(), tid = wid * 64 + lane, wr = wid >> 2, wc = wid & 3, fr = lane & 15, fq = lane >> 4;
    const int K = g.K, nt = K / BK;
    unsigned voffA[2], voffB[2];
#pragma unroll
    for (int i = 0; i < 2; ++i) { int R, C; stage_rc(tid * 16 + i * 8192, R, C); const int Rb = Epi::PERM ? ((R & ~31) + perm32(R & 31)) : R;
        voffA[i] = (unsigned)(R * K + C) * 2u; voffB[i] = (unsigned)(Rb * K + C) * 2u; }
    const size_t kstep = (size_t)(BK * 2);
    const size_t hstep = (size_t)HALF * K * 2;
    const size_t tstep = 2 * hstep;
    const unsigned ldsw = (unsigned)wid * 1024u;
    const int aoff = lds_byte(wr * 64 + fr, fq * 8), boff = lds_byte(wc * 32 + fr, fq * 8);
#define PG8_SA(b, h) (((b) * 2 + (h)) * HTB)
#define PG8_SB(b, h) ((4 + (b) * 2 + (h)) * HTB)
#define PG8_STAGE(bufoff, gbase, voff) do { _Pragma("unroll") for (int _i = 0; _i < 2; ++_i) \
        __builtin_amdgcn_global_load_lds((const unsigned*)((const char*)(gbase) + (voff)[_i]), (PG8_LAS unsigned*)(lds + (bufoff) + ldsw + _i * 8192), 16, 0, 0); } while (0)
#define PG8_LDA(dst, b, h) do { _Pragma("unroll") for (int m = 0; m < 4; ++m) _Pragma("unroll") for (int k = 0; k < 2; ++k) dst[m][k] = *(const PG8_LAS bf16x8*)(lds + PG8_SA(b, h) + aoff + m * 2048 + k * 1024); } while (0)
#define PG8_LDB(dst, b, h) do { _Pragma("unroll") for (int n = 0; n < 2; ++n) _Pragma("unroll") for (int k = 0; k < 2; ++k) dst[n][k] = *(const PG8_LAS bf16x8*)(lds + PG8_SB(b, h) + boff + n * 2048 + k * 1024); } while (0)
#define PG8_MMA(ai, bj, At, Bt) do { __builtin_amdgcn_s_setprio(1); _Pragma("unroll") for (int m = 0; m < 4; ++m) _Pragma("unroll") for (int n = 0; n < 2; ++n) _Pragma("unroll") for (int k = 0; k < 2; ++k) \
        acc[ai][bj][m][n] = __builtin_amdgcn_mfma_f32_16x16x32_bf16(Bt[n][k], At[m][k], acc[ai][bj][m][n], 0, 0, 0); __builtin_amdgcn_s_setprio(0); } while (0)
#define PG8_WAIT_V(n) asm volatile("s_waitcnt vmcnt(" #n ")" ::: "memory")
#define PG8_WAIT_L(n) asm volatile("s_waitcnt lgkmcnt(" #n ")" ::: "memory")
#define PG8_BAR __builtin_amdgcn_s_barrier()
#define PG8_SCHED __builtin_amdgcn_sched_barrier(0)
    Unit cur, nxt; int ui = 0;
    if (!S.next(0, cur)) return;
    f32x4 acc[2][2][4][2];
#pragma unroll
    for (int a = 0; a < 2; ++a)
#pragma unroll
        for (int b = 0; b < 2; ++b)
#pragma unroll
            for (int m = 0; m < 4; ++m)
#pragma unroll
                for (int n = 0; n < 2; ++n) acc[a][b][m][n] = (f32x4){0.f, 0.f, 0.f, 0.f};
    bf16x8 At[4][2], B0[2][2], B1[2][2];
    const char* cA = (const char*)g.A + (size_t)cur.pm * tstep; const char* cB = (const char*)g.Bt + (size_t)cur.pn * tstep;
    S.a_ready(cur);
    if constexpr (SP2) {
        PG8_STAGE(PG8_SB(0, 0), cB, voffB); PG8_STAGE(PG8_SB(0, 1), cB + hstep, voffB); PG8_STAGE(PG8_SA(0, 0), cA, voffA); PG8_STAGE(PG8_SA(0, 1), cA + hstep, voffA);
        if (wr == 1) PG8_BAR;
        PG8_WAIT_V(2); PG8_BAR;
        PG8_STAGE(PG8_SB(1, 0), cB + kstep, voffB); PG8_STAGE(PG8_SA(1, 0), cA + kstep, voffA); PG8_STAGE(PG8_SB(1, 1), cB + hstep + kstep, voffB);
        PG8_WAIT_V(6); PG8_BAR;
    } else {
        PG8_STAGE(PG8_SB(0, 0), cB, voffB); PG8_STAGE(PG8_SA(0, 0), cA, voffA); PG8_STAGE(PG8_SB(0, 1), cB + hstep, voffB); PG8_STAGE(PG8_SA(0, 1), cA + hstep, voffA);
        if (wr == 1) PG8_BAR;
        PG8_WAIT_V(4); PG8_BAR;
        PG8_STAGE(PG8_SB(1, 0), cB + kstep, voffB); PG8_STAGE(PG8_SA(1, 0), cA + kstep, voffA); PG8_STAGE(PG8_SB(1, 1), cB + hstep + kstep, voffB);
        PG8_WAIT_V(6); PG8_BAR;
    }
    for (;;) {
        const bool has_next = S.next(ui + 1, nxt);
        const char* nA = has_next ? (const char*)g.A + (size_t)nxt.pm * tstep : cA; const char* nB = has_next ? (const char*)g.Bt + (size_t)nxt.pn * tstep : cB;
        for (int t = 0; t < nt; t += 2) {
            const bool last = (t == nt - 2);
            const char* a1 = cA + (size_t)(t + 1) * kstep;
            const char* a2 = last ? nA : cA + (size_t)(t + 2) * kstep; const char* b2 = last ? nB : cB + (size_t)(t + 2) * kstep;
            const char* a3 = a2 + kstep; const char* b3 = b2 + kstep;
            if (last && has_next) S.a_ready(nxt);
            if constexpr (SP2) {
            PG8_LDB(B0, 0, 0); PG8_LDB(B1, 0, 1); PG8_SCHED; PG8_LDA(At, 0, 0); PG8_STAGE(PG8_SA(1, 1), a1 + hstep, voffA);
            PG8_WAIT_V(8); PG8_WAIT_L(0); PG8_BAR; PG8_MMA(0, 0, At, B0); PG8_MMA(0, 1, At, B1); PG8_BAR; PG8_SCHED;
            PG8_LDA(At, 0, 1); PG8_STAGE(PG8_SB(0, 0), b2, voffB); PG8_STAGE(PG8_SB(0, 1), b2 + hstep, voffB); PG8_STAGE(PG8_SA(0, 0), a2, voffA);
            PG8_WAIT_V(8); PG8_WAIT_L(0); PG8_BAR; PG8_MMA(1, 0, At, B0); PG8_MMA(1, 1, At, B1); PG8_BAR; PG8_SCHED;
            PG8_LDB(B0, 1, 0); PG8_LDB(B1, 1, 1); PG8_SCHED; PG8_LDA(At, 1, 0); PG8_STAGE(PG8_SA(0, 1), a2 + hstep, voffA);
            PG8_WAIT_V(8); PG8_WAIT_L(0); PG8_BAR; PG8_MMA(0, 0, At, B0); PG8_MMA(0, 1, At, B1); PG8_BAR; PG8_SCHED;
            PG8_LDA(At, 1, 1); PG8_STAGE(PG8_SB(1, 0), b3, voffB); PG8_STAGE(PG8_SB(1, 1), b3 + hstep, voffB); PG8_STAGE(PG8_SA(1, 0), a3, voffA);
            PG8_WAIT_V(8); PG8_WAIT_L(0); PG8_BAR; PG8_MMA(1, 0, At, B0); PG8_MMA(1, 1, At, B1); PG8_BAR; PG8_SCHED;
            } else {
            PG8_LDB(B0, 0, 0); PG8_SCHED; PG8_LDA(At, 0, 0); PG8_STAGE(PG8_SA(1, 1), a1 + hstep, voffA);
            PG8_WAIT_L(8); PG8_BAR; PG8_WAIT_L(0); PG8_MMA(0, 0, At, B0); PG8_BAR; PG8_SCHED;
            PG8_LDB(B1, 0, 1); PG8_STAGE(PG8_SB(0, 0), b2, voffB);
            PG8_BAR; PG8_WAIT_L(0); PG8_MMA(0, 1, At, B1); PG8_BAR;
            PG8_LDA(At, 0, 1); PG8_STAGE(PG8_SA(0, 0), a2, voffA);
            PG8_BAR; PG8_WAIT_L(0); PG8_MMA(1, 0, At, B0); PG8_BAR; PG8_SCHED;
            PG8_STAGE(PG8_SB(0, 1), b2 + hstep, voffB);
            PG8_WAIT_V(6); PG8_BAR; PG8_MMA(1, 1, At, B1); PG8_BAR;
            PG8_LDB(B0, 1, 0); PG8_SCHED; PG8_LDA(At, 1, 0); PG8_STAGE(PG8_SA(0, 1), a2 + hstep, voffA);
            PG8_WAIT_L(8); PG8_BAR; PG8_WAIT_L(0); PG8_MMA(0, 0, At, B0); PG8_BAR; PG8_SCHED;
            PG8_LDB(B1, 1, 1); PG8_STAGE(PG8_SB(1, 0), b3, voffB);
            PG8_BAR; PG8_WAIT_L(0); PG8_MMA(0, 1, At, B1); PG8_BAR;
            PG8_LDA(At, 1, 1); PG8_STAGE(PG8_SA(1, 0), a3, voffA);
            PG8_BAR; PG8_WAIT_L(0); PG8_MMA(1, 0, At, B0); PG8_BAR; PG8_SCHED;
            PG8_STAGE(PG8_SB(1, 1), b3 + hstep, voffB);
            PG8_WAIT_V(6); PG8_BAR; PG8_MMA(1, 1, At, B1); PG8_BAR;
            }
        }
        if constexpr (ALIGN_EPI) { if (wr == 0) PG8_BAR; }
        if constexpr (!Epi::AFTER_DRAIN) { E(acc, cur, wr, wc, fr, fq); S.done(cur); }
        if (!has_next) break;
#pragma unroll
        for (int a = 0; a < 2; ++a)
#pragma unroll
            for (int b = 0; b < 2; ++b)
#pragma unroll
                for (int m = 0; m < 4; ++m)
#pragma unroll
                    for (int n = 0; n < 2; ++n) acc[a][b][m][n] = (f32x4){0.f, 0.f, 0.f, 0.f};
        cur = nxt; cA = nA; cB = nB; ++ui;
        if constexpr (ALIGN_EPI) { if (wr == 1) PG8_BAR; }
    }
    PG8_WAIT_V(0);
    if constexpr (!ALIGN_EPI) { if (wr == 0) PG8_BAR; }
    PG8_BAR;
    if constexpr (Epi::AFTER_DRAIN) { E.fused(acc, cur, wr, wc, fr, fq, lds, wid, lane); S.done(cur); }
#undef PG8_SA
#undef PG8_SB
#undef PG8_STAGE
#undef PG8_LDA
#undef PG8_LDB
#undef PG8_MMA
#undef PG8_WAIT_V
#undef PG8_WAIT_L
#undef PG8_BAR
#undef PG8_SCHED
}
}

#include <hip/hip_bf16.h>
namespace attn_body {
using bf16=__hip_bfloat16;
using bf16x8=__attribute__((ext_vector_type(8)))short;
using s16x4=__attribute__((ext_vector_type(4)))short;
using f32x16=__attribute__((ext_vector_type(16)))float;
using u32x4=__attribute__((ext_vector_type(4)))unsigned;
constexpr int BATCH=4,NHEAD=16,SEQ=4096,D=64,DM=NHEAD*D;
constexpr int NW=8,QBLK=32,QB=QBLK*NW,KVBLK=64,NQB=SEQ/QB;
constexpr int ATTN_PITCH=DM, ATTN_UNIT_ROWS=QB;
__device__ __forceinline__ int crow(int r,int hi){return (r&3)+8*(r>>2)+4*hi;}
#define SBAR() __builtin_amdgcn_sched_barrier(0)
__device__ __forceinline__ void cmask(f32x16&p0,f32x16&p1,int jb,int qrel,int hi){
  const float NEG=-INFINITY; int kb=64*jb+4*hi;
  #pragma unroll
  for(int r=0;r<16;++r){int kv=kb+(r&3)+8*(r>>2); if(kv>qrel)p0[r]=NEG; if(kv+32>qrel)p1[r]=NEG;}
}

constexpr int NSLOT=3, SLOTB=8192;
constexpr int LDS_K=0, LDS_V=NSLOT*SLOTB, LDS_WS=2*NSLOT*SLOTB, LDS_OST=LDS_WS+NW*64*4, LDS_BYTES=LDS_OST+NW*4096;
constexpr float C2=0.125f*1.4426950408889634f;
__device__ __forceinline__ void glds16(const void*gsrc,unsigned lds_dst){unsigned keep;
  asm volatile("s_mov_b32 %0, m0\n\ts_mov_b32 m0, %2\n\ts_nop 0\n\tglobal_load_lds_dwordx4 %1, off\n\ts_mov_b32 m0, %0":"=&s"(keep):"v"(gsrc),"s"(lds_dst):"memory");}
__device__ __forceinline__ float max3f(float a,float b,float c){float r;asm("v_max3_f32 %0, %1, %2, %3":"=v"(r):"v"(a),"v"(b),"v"(c));return r;}
__device__ __forceinline__ float max2f(float a,float b){float r;asm("v_max_f32_e32 %0, %1, %2":"=v"(r):"v"(a),"v"(b));return r;}
__device__ __forceinline__ float fadd_s(float a,float b){float r;asm("v_add_f32_e32 %0, %1, %2":"=v"(r):"v"(a),"v"(b));return r;}
__device__ __forceinline__ float fsub_s(float a,float b){float r;asm("v_sub_f32_e32 %0, %1, %2":"=v"(r):"v"(a),"v"(b));return r;}
typedef float f32x2_t __attribute__((ext_vector_type(2))); typedef __bf16 bf16x2_t __attribute__((ext_vector_type(2)));
__device__ __forceinline__ unsigned cvtpk_s(float lo,float hi){f32x2_t v={lo,hi};bf16x2_t b=__builtin_convertvector(v,bf16x2_t);return __builtin_bit_cast(unsigned,b);}
#define WAIT_BAR(N) asm volatile("s_waitcnt vmcnt(" #N ") lgkmcnt(0)\n\ts_barrier":::"memory")

__device__ __forceinline__ void qkt(f32x16&p0,f32x16&p1,const char*Kslot,const bf16x8*qr,int r32,int hi){
  const char*kb=Kslot+hi*1024+r32*16;
  #pragma unroll
  for(int d0=0;d0<4;++d0){
    const bf16x8 b0=*reinterpret_cast<const bf16x8*>(kb+d0*2048);
    const bf16x8 b1=*reinterpret_cast<const bf16x8*>(kb+d0*2048+512);
    p0=__builtin_amdgcn_mfma_f32_32x32x16_bf16(b0,qr[d0],p0,0,0,0);p1=__builtin_amdgcn_mfma_f32_32x32x16_bf16(b1,qr[d0],p1,0,0,0);}
}
typedef __attribute__((address_space(3))) const char* lds_cptr;
typedef short v4i16_t __attribute__((ext_vector_type(4)));
__device__ __forceinline__ void kload8(bf16x8*kf,lds_cptr kp){
  kf[0]=*(const __attribute__((address_space(3))) bf16x8*)(kp);      kf[1]=*(const __attribute__((address_space(3))) bf16x8*)(kp+512);
  kf[2]=*(const __attribute__((address_space(3))) bf16x8*)(kp+2048); kf[3]=*(const __attribute__((address_space(3))) bf16x8*)(kp+2560);
  kf[4]=*(const __attribute__((address_space(3))) bf16x8*)(kp+4096); kf[5]=*(const __attribute__((address_space(3))) bf16x8*)(kp+4608);
  kf[6]=*(const __attribute__((address_space(3))) bf16x8*)(kp+6144); kf[7]=*(const __attribute__((address_space(3))) bf16x8*)(kp+6656);
}
__device__ __forceinline__ void kload2(bf16x8*kf,lds_cptr kp,int j){ kf[2*j]=*(const __attribute__((address_space(3))) bf16x8*)(kp+j*2048); kf[2*j+1]=*(const __attribute__((address_space(3))) bf16x8*)(kp+j*2048+512); }
__device__ __forceinline__ s16x4 vtr(lds_cptr p){ return __builtin_bit_cast(s16x4,__builtin_amdgcn_ds_read_tr16_b64_v4i16((__attribute__((address_space(3))) v4i16_t*)p)); }
__device__ __forceinline__ float rowmax(const f32x16&p0,const f32x16&p1){
  float a=max3f(p0[0],p0[1],p1[0]),b=max3f(p0[2],p0[3],p1[1]);a=max3f(a,p1[2],p1[3]);
  #pragma unroll
  for(int r=4;r<16;r+=4){a=max3f(a,p0[r],p0[r+1]);b=max3f(b,p0[r+2],p0[r+3]);a=max3f(a,p1[r],p1[r+1]);b=max3f(b,p1[r+2],p1[r+3]);}
  const float m=max2f(a,b);
  auto rr=__builtin_amdgcn_permlane32_swap(__float_as_uint(m),__float_as_uint(m),false,false);
  return max2f(__uint_as_float(rr[0]),__uint_as_float(rr[1]));
}
__device__ __forceinline__ void pv(f32x16*o,int vb,bf16x8 pa0,bf16x8 pa1,bf16x8 pa2,bf16x8 pa3){
  #pragma unroll
  for(int d0=0;d0<2;++d0){s16x4 lo[4],hi[4];
    #pragma unroll
    for(int ks=0;ks<4;++ks){
      asm volatile("ds_read_b64_tr_b16 %0,%1 offset:%c2":"=&v"(lo[ks]):"v"(vb),"i"(d0*4096+ks*1024):"memory");
      asm volatile("ds_read_b64_tr_b16 %0,%1 offset:%c2":"=&v"(hi[ks]):"v"(vb),"i"(d0*4096+ks*1024+512):"memory");}
    asm volatile("s_waitcnt lgkmcnt(0)":::"memory");SBAR();
    #define PK(k) (bf16x8){lo[k][0],lo[k][1],lo[k][2],lo[k][3],hi[k][0],hi[k][1],hi[k][2],hi[k][3]}
    o[d0]=__builtin_amdgcn_mfma_f32_32x32x16_bf16(pa0,PK(0),o[d0],0,0,0);
    o[d0]=__builtin_amdgcn_mfma_f32_32x32x16_bf16(pa1,PK(1),o[d0],0,0,0);
    o[d0]=__builtin_amdgcn_mfma_f32_32x32x16_bf16(pa2,PK(2),o[d0],0,0,0);
    o[d0]=__builtin_amdgcn_mfma_f32_32x32x16_bf16(pa3,PK(3),o[d0],0,0,0);
    #undef PK
  }
}

#ifndef ATTN_STORE16
#define ATTN_STORE16(p,v) (*(u32x4*)(p)=(v))
#endif
typedef __attribute__((address_space(3))) const float* lds_cfptr; typedef float f32x4_t __attribute__((ext_vector_type(4)));
constexpr float MFLOOR=-100.f;
template<int THRL> __device__ __forceinline__ void attn_unit(int b,int h,int qb,const bf16*Q,const bf16*__restrict__ K,const bf16*__restrict__ V,bf16*O,char*shm,lds_cfptr cum,const int wid){
  const int lane=pg8::pg8_lane_id(),r32=lane&31,hi=lane>>5;
  const long rowbase=(long)b*SEQ; const int q0=qb*QB;
  const bf16*Qw=Q+(rowbase+q0+wid*QBLK)*DM+h*D;
  const bf16*Kh=K+rowbase*DM+h*D,*Vh=V+rowbase*DM+h*D;
  const unsigned lds0=(unsigned)(uintptr_t)shm;
  float*wsf=(float*)(shm+LDS_WS)+wid*64;
  const bf16*ksrc=Kh+(long)lane*DM+wid*8;
  const bf16*vsrc=Vh+(long)(16*(wid&3)+(lane>>2))*DM+(wid>>2)*32+(lane&3)*8;
  const unsigned kdst=lds0+LDS_K+wid*1024, vdst=lds0+LDS_V+wid*1024;
  #define DMA_K(t,slot) glds16(ksrc+(long)(NT-1-(t))*KVBLK*DM,(unsigned)__builtin_amdgcn_readfirstlane(kdst+(slot)))
  #define DMA_V(t,slot) glds16(vsrc+(long)(NT-1-(t))*KVBLK*DM,(unsigned)__builtin_amdgcn_readfirstlane(vdst+(slot)))
  const char*Kbase=shm+LDS_K; bf16x8 kf[8];
  const lds_cptr shm3=(lds_cptr)shm; const lds_cptr kp0=shm3+LDS_K+hi*1024+r32*16; const lds_cptr vp0=shm3+LDS_V+((lane>>4)&1)*32+(lane&3)*8+(4*hi+((lane&15)>>2))*64;
  const int NT=(q0+QB)/KVBLK;
  DMA_K(0,0);DMA_V(0,0);DMA_K(1,SLOTB);
  bf16x8 qr[4];
  #pragma unroll
  for(int d0=0;d0<4;++d0)qr[d0]=*reinterpret_cast<const bf16x8*>(&Qw[(long)r32*DM+d0*16+hi*8]);
  float l_reg=0.f;f32x16 o[2];o[0]=f32x16{};o[1]=f32x16{};
  float cbase=cum[q0+wid*QBLK+r32];
  #define CINITH(CX,t,OFS) do{ const lds_cfptr cb_=cum+(NT-1-(t))*KVBLK+4*hi+(OFS); const float bs_=cbase; \
    _Pragma("unroll") for(int g_=0;g_<4;++g_){ const f32x4_t a_=*(const __attribute__((address_space(3))) f32x4_t*)(cb_+8*g_); \
      CX[4*g_]=bs_-a_[0];CX[4*g_+1]=bs_-a_[1];CX[4*g_+2]=bs_-a_[2];CX[4*g_+3]=bs_-a_[3]; } }while(0)
  #define CINIT(C0,C1,t) do{ CINITH(C0,t,0); CINITH(C1,t,32); }while(0)
  const int qrel=wid*QBLK+r32;
  #define CMASK(P0,P1,t) do{int jb_=3-(t); if(jb_>=0)cmask(P0,P1,jb_,qrel,hi);}while(0)
  bool resc=false;
  #define START(P0,P1) do{ const float rm=rowmax(P0,P1); resc=false; \
    { const float dl=max2f(rm,MFLOOR); cbase=fsub_s(cbase,dl); \
      _Pragma("unroll") for(int r=0;r<16;++r){P0[r]=fsub_s(P0[r],dl);P1[r]=fsub_s(P1[r],dl);} } \
    _Pragma("unroll") for(int r=0;r<16;++r)P0[r]=__builtin_amdgcn_exp2f(P0[r]); }while(0)
  #define RESC() do{ if(resc){ asm volatile("s_waitcnt lgkmcnt(0)":::"memory"); const int hx_=pg8::pg8_lane_id()>>5; \
      _Pragma("unroll") for(int d_=0;d_<2;++d_) _Pragma("unroll") for(int r=0;r<16;++r)o[d_][r]*=wsf[crow(r,hx_)]; } }while(0)
  f32x16 pA0,pA1,pB0,pB1;
  int sl_prev=0,sl_cur=0,sl_next=SLOTB;
  #define ROT() do{sl_prev=sl_cur;sl_cur=sl_next;sl_next=(sl_next==(NSLOT-1)*SLOTB)?0:sl_next+SLOTB;}while(0)
  DMA_K(2,2*SLOTB);
  WAIT_BAR(3);
  CINIT(pA0,pA1,0); qkt(pA0,pA1,Kbase,qr,r32,hi);asm volatile("s_nop 15\n\ts_nop 7":"+v"(pA0),"+v"(pA1));CMASK(pA0,pA1,0);
  START(pA0,pA1);
  _Pragma("unroll") for(int r=0;r<16;++r)pA1[r]=__builtin_amdgcn_exp2f(pA1[r]);
  WAIT_BAR(0);
  DMA_K(3,0);DMA_V(1,SLOTB);
  ROT();
  kload8(kf,kp0+sl_cur);
  WAIT_BAR(2);
  s16x4 vlo[8],vhi[8]; u32x4 pw0,pw1,pw2,pw3;
  #define PKW(P,B) cvtpk_s(P[B],P[B+1])
  #define PAF(k) __builtin_bit_cast(bf16x8,pw##k)
  #define VFR(i) (bf16x8){vlo[i][0],vlo[i][1],vlo[i][2],vlo[i][3],vhi[i][0],vhi[i][1],vhi[i][2],vhi[i][3]}
  #define PIN(x) asm volatile("":"+v"(x))
  #define MX3(a,b,c) __builtin_fmaxf(__builtin_fmaxf((a),(b)),(c))
  #define GAPA(MF,A0,A1,A2,A3,W0,W1,PW) do{ MF; sacc+=A0; sacc+=A1; sacc+=A2; sacc+=A3; PIN(sacc); W0; W1; PIN(PW); SBAR(); }while(0)
  #define EX(v) __builtin_amdgcn_exp2f(v)
  #define GAPB(MF,X,B) do{ MF; X[B]=EX(X[B]); X[B+1]=EX(X[B+1]); X[B+2]=EX(X[B+2]); X[B+3]=EX(X[B+3]); PIN(X); SBAR(); }while(0)
  #define VRD(i) do{ vlo[i]=vtr(vp_+(((i)>>2)*4096+((i)&3)*1024)); vhi[i]=vtr(vp_+(((i)>>2)*4096+((i)&3)*1024+512)); }while(0)
  #define KRD(G,j) do{ if(G){ kload2(kf,kp0+sl_next,j); SBAR(); } }while(0)
  #define STEP(C0,C1,P0,P1,t,GK,GV,GL) do{ CINITH(C0,t,0); SBAR(); \
    const lds_cptr vp_=vp0+sl_prev; \
    VRD(0); SBAR(); float sacc=(P0[0]+P0[1]); \
    GAPA(C0=__builtin_amdgcn_mfma_f32_32x32x16_bf16(kf[0],qr[0],C0,0,0,0), P0[2],P0[3],P0[4],P0[5],     pw0[0]=PKW(P0,0), pw0[1]=PKW(P0,2), pw0); \
    CINITH(C1,t,32); SBAR(); VRD(4); SBAR(); GAPA(C1=__builtin_amdgcn_mfma_f32_32x32x16_bf16(kf[1],qr[0],C1,0,0,0), P0[6],P0[7],P0[8],P0[9],     pw0[2]=PKW(P0,4), pw0[3]=PKW(P0,6), pw0); \
    VRD(1); SBAR(); GAPA(C0=__builtin_amdgcn_mfma_f32_32x32x16_bf16(kf[2],qr[1],C0,0,0,0),   P0[10],P0[11],P0[12],P0[13], pw1[0]=PKW(P0,8), pw1[1]=PKW(P0,10), pw1); \
    VRD(5); SBAR(); GAPA(C1=__builtin_amdgcn_mfma_f32_32x32x16_bf16(kf[3],qr[1],C1,0,0,0),   P0[14],P0[15],P1[0],P1[1],   pw1[2]=PKW(P0,12),pw1[3]=PKW(P0,14), pw1); \
    VRD(2); SBAR(); GAPA(C0=__builtin_amdgcn_mfma_f32_32x32x16_bf16(kf[4],qr[2],C0,0,0,0),   P1[2],P1[3],P1[4],P1[5],     pw2[0]=PKW(P1,0), pw2[1]=PKW(P1,2), pw2); \
    VRD(6); SBAR(); GAPA(C1=__builtin_amdgcn_mfma_f32_32x32x16_bf16(kf[5],qr[2],C1,0,0,0),   P1[6],P1[7],P1[8],P1[9],     pw2[2]=PKW(P1,4), pw2[3]=PKW(P1,6), pw2); \
    VRD(3); SBAR(); GAPA(C0=__builtin_amdgcn_mfma_f32_32x32x16_bf16(kf[6],qr[3],C0,0,0,0),   P1[10],P1[11],P1[12],P1[13], pw3[0]=PKW(P1,8), pw3[1]=PKW(P1,10), pw3); \
    VRD(7); SBAR(); GAPA(C1=__builtin_amdgcn_mfma_f32_32x32x16_bf16(kf[7],qr[3],C1,0,0,0),   P1[14],P1[15],0.f,0.f,       pw3[2]=PKW(P1,12),pw3[3]=PKW(P1,14), pw3); \
    l_reg+=sacc; \
    if(GK){DMA_K((t)+3,sl_cur);} if(GV){DMA_V((t)+1,sl_next);} \
    CMASK(C0,C1,t); \
    { float a=MX3(C0[0],C0[1],C1[0]),b=MX3(C0[2],C0[3],C1[1]); a=MX3(a,C1[2],C1[3]); \
      _Pragma("unroll") for(int r=4;r<16;r+=4){a=MX3(a,C0[r],C0[r+1]);b=MX3(b,C0[r+2],C0[r+3]);a=MX3(a,C1[r],C1[r+1]);b=MX3(b,C1[r+2],C1[r+3]);} \
      float rm=__builtin_fmaxf(a,b); { auto rr=__builtin_amdgcn_permlane32_swap(__float_as_uint(rm),__float_as_uint(rm),false,false); rm=__builtin_fmaxf(__uint_as_float(rr[0]),__uint_as_float(rr[1])); } \
      resc=false; \
      if(__builtin_expect(__any(rm>(float)THRL),0)){ const float dl=__builtin_fmaxf(rm,0.f); cbase-=dl; \
        _Pragma("unroll") for(int r=0;r<16;++r){C0[r]-=dl;C1[r]-=dl;} \
        const float f=__builtin_amdgcn_exp2f(-dl); l_reg*=f; { const int lx_=pg8::pg8_lane_id(); if(lx_<32)wsf[lx_]=f; } resc=true; } } \
    SBAR(); \
    GAPB(o[0]=__builtin_amdgcn_mfma_f32_32x32x16_bf16(PAF(0),VFR(0),o[0],0,0,0), C0,0); \
    GAPB(o[1]=__builtin_amdgcn_mfma_f32_32x32x16_bf16(PAF(0),VFR(4),o[1],0,0,0), C0,4); \
    KRD(GL,0); GAPB(o[0]=__builtin_amdgcn_mfma_f32_32x32x16_bf16(PAF(1),VFR(1),o[0],0,0,0), C0,8); \
    KRD(GL,1); GAPB(o[1]=__builtin_amdgcn_mfma_f32_32x32x16_bf16(PAF(1),VFR(5),o[1],0,0,0), C0,12); \
    KRD(GL,2); GAPB(o[0]=__builtin_amdgcn_mfma_f32_32x32x16_bf16(PAF(2),VFR(2),o[0],0,0,0), C1,0); \
    KRD(GL,3); GAPB(o[1]=__builtin_amdgcn_mfma_f32_32x32x16_bf16(PAF(2),VFR(6),o[1],0,0,0), C1,4); \
    GAPB(o[0]=__builtin_amdgcn_mfma_f32_32x32x16_bf16(PAF(3),VFR(3),o[0],0,0,0), C1,8); \
    GAPB(o[1]=__builtin_amdgcn_mfma_f32_32x32x16_bf16(PAF(3),VFR(7),o[1],0,0,0), C1,12); \
    }while(0)
  int t=1;
  #define ENDW(tt) do{ if((tt)+3<NT){WAIT_BAR(2);} else if((tt)+2<NT){WAIT_BAR(1);} else {WAIT_BAR(0);} }while(0)
  for(;t<5&&t+1<NT;t+=2){
    STEP(pB0,pB1,pA0,pA1,t,(t+3<NT),(t+1<NT),(t+1<NT));       ENDW(t);   RESC(); ROT();
    STEP(pA0,pA1,pB0,pB1,t+1,(t+4<NT),(t+2<NT),(t+2<NT));     ENDW(t+1); RESC(); ROT();
  }
  #undef CMASK
  #define CMASK(P0,P1,t) do{}while(0)
  for(;t+5<NT;t+=2){
    STEP(pB0,pB1,pA0,pA1,t,true,true,true);     WAIT_BAR(2); RESC(); ROT();
    STEP(pA0,pA1,pB0,pB1,t+1,true,true,true);   WAIT_BAR(2); RESC(); ROT();
  }
  for(;t+1<NT;t+=2){
    STEP(pB0,pB1,pA0,pA1,t,(t+3<NT),(t+1<NT),(t+1<NT));       ENDW(t);   RESC(); ROT();
    STEP(pA0,pA1,pB0,pB1,t+1,(t+4<NT),(t+2<NT),(t+2<NT));     ENDW(t+1); RESC(); ROT();
  }
  #undef CMASK
  #define CMASK(P0,P1,t) do{int jb_=3-(t); if(jb_>=0)cmask(P0,P1,jb_,qrel,hi);}while(0)
  STEP(pB0,pB1,pA0,pA1,NT-1,false,false,false); RESC();
  { float sacc=pB0[0]+pB0[1]; _Pragma("unroll") for(int r=2;r<16;++r)sacc+=pB0[r]; _Pragma("unroll") for(int r=0;r<16;++r)sacc+=pB1[r]; l_reg+=sacc;
    pw0=(u32x4){PKW(pB0,0),PKW(pB0,2),PKW(pB0,4),PKW(pB0,6)};pw1=(u32x4){PKW(pB0,8),PKW(pB0,10),PKW(pB0,12),PKW(pB0,14)};pw2=(u32x4){PKW(pB1,0),PKW(pB1,2),PKW(pB1,4),PKW(pB1,6)};pw3=(u32x4){PKW(pB1,8),PKW(pB1,10),PKW(pB1,12),PKW(pB1,14)};
    SBAR(); const int ld_=pg8::pg8_lane_id(); const int vb0=(int)(lds0+LDS_V)+((ld_>>4)&1)*32+(ld_&3)*8+(4*(ld_>>5)+((ld_&15)>>2))*64; pv(o,vb0+sl_cur,PAF(0),PAF(1),PAF(2),PAF(3)); }
  #undef PKW
  #undef PAF
  #undef VFR
  #undef PIN
  #undef MX3
  #undef GAPA
  #undef GAPB
  #undef EX
  #undef VRD
  #undef KRD
  #undef STEP
  #undef ENDW
  {auto rr=__builtin_amdgcn_permlane32_swap(__float_as_uint(l_reg),__float_as_uint(l_reg),false,false);l_reg=__uint_as_float(rr[0])+__uint_as_float(rr[1]);}
  const int le_=pg8::pg8_lane_id(),r32e=le_&31,hie=le_>>5;
  if(hie==0)wsf[32+r32e]=l_reg;asm volatile("s_waitcnt lgkmcnt(0)":::"memory");
  float rli[16];
  #pragma unroll
  for(int r=0;r<16;++r)rli[r]=__builtin_amdgcn_rcpf(wsf[32+crow(r,hie)]);
  bf16*Ow=O+(rowbase+q0+wid*QBLK)*DM+h*D;
  { bf16*stg=(bf16*)(shm+LDS_OST)+wid*2048;
    #pragma unroll
    for(int r=0;r<16;++r){const int orow=crow(r,hie);
      #pragma unroll
      for(int d0=0;d0<2;++d0)stg[orow*64+d0*32+r32e]=__float2bfloat16(o[d0][r]*rli[r]);}
    asm volatile("s_waitcnt lgkmcnt(0)":::"memory");
    #pragma unroll
    for(int i=0;i<4;++i){const int row=i*8+(le_>>3),ch=le_&7; const u32x4 v=*(const u32x4*)(stg+row*64+ch*8); ATTN_STORE16(Ow+(long)row*DM+ch*8,v);} }
  asm volatile("s_waitcnt lgkmcnt(0)\n\ts_barrier":::"memory");
  #undef DMA_K
  #undef DMA_V
  #undef CMASK
  #undef START
  #undef RESC
  #undef ROT
  #undef CINIT
  #undef CINITH
}
constexpr int ATTN_LDS_BYTES=LDS_BYTES;
struct AttnTensors { const bf16* Q; const bf16* K; const bf16* V; bf16* O; };
struct AttnUnit { int bh; int qb; };
__device__ __forceinline__ void attn_phase(char*lds,const AttnTensors&T,const float*logft,__attribute__((address_space(3))) float*cum,__attribute__((address_space(3))) float*part,int v,int G,const int wid){
  typedef float f4 __attribute__((ext_vector_type(4)));
  for(int pb=v;pb<BATCH*NHEAD*4;pb+=G){
    const int bh=pb>>2,s=pb&3;
    { const int lane=pg8::pg8_lane_id(),tid=wid*64+lane;
      const f4*p=(const f4*)(logft+(size_t)bh*SEQ)+2*tid; const f4 a=p[0],b=p[1];
      float w[8]; w[0]=a.x; w[1]=w[0]+a.y; w[2]=w[1]+a.z; w[3]=w[2]+a.w; w[4]=w[3]+b.x; w[5]=w[4]+b.y; w[6]=w[5]+b.z; w[7]=w[6]+b.w;
      float incl=w[7];
      #pragma unroll
      for(int o=1;o<64;o<<=1){ const float t_=__builtin_bit_cast(float,__builtin_amdgcn_ds_bpermute((lane-o)*4,__builtin_bit_cast(int,incl))); if(lane>=o)incl+=t_; }
      if(lane==63)part[wid]=incl;
      __syncthreads();
      float base=incl-w[7];
      #pragma unroll
      for(int k=0;k<8;++k) if(k<wid) base+=part[k];
      #pragma unroll
      for(int k=0;k<8;++k) cum[8*tid+k]=w[k]+base;
      __syncthreads(); }
    #pragma unroll 1
    for(int i=0;i<4;++i){ const int qb=(i==0)?s:(i==1)?7-s:(i==2)?8+s:15-s; attn_unit<8>(bh/NHEAD,bh%NHEAD,qb,T.Q,T.K,T.V,T.O,lds,(lds_cfptr)cum,wid); }
    __syncthreads();
  }
}
#undef SBAR
#undef WAIT_BAR
}

constexpr int NWAVES = 8;
constexpr int D = 1024, NB = 4, S = 4096, M = NB * S, FF = 3584, NE = 8, NH = 16;
constexpr int NMOD = 6 * D;
constexpr float C2 = 0.125f * 1.4426950408889634f;
constexpr float LOG2E = 1.4426950408889634f;
constexpr float RMS_EPS = 1e-6f;
constexpr int ECAP = 16384;

constexpr size_t MiB = 1u << 20;
constexpr size_t WS_CTL = 0, CTL_ZERO_BYTES = 1 * MiB;
constexpr size_t WS_MOD = 1 * MiB;
constexpr size_t WS_WFT = 1 * MiB + 512 * 1024;
constexpr size_t WS_LIST = 2 * MiB, WS_WL = 2 * MiB + 512 * 1024;
constexpr size_t WS_LOGFT = 3 * MiB;
constexpr size_t WS_WFOXIN = 4 * MiB, WS_WFOXOUT = 10 * MiB, WS_WSWAIN = 12 * MiB, WS_WSWAOUT = 15 * MiB, WS_WGU = 17 * MiB, WS_WDN = 31 * MiB;
constexpr size_t WS_WMGU = 38 * MiB, WS_WMDN = 150 * MiB;
constexpr size_t WS_XA = 206 * MiB;
constexpr size_t WS_YS = 270 * MiB;
constexpr size_t WS_XN = 334 * MiB;
constexpr size_t WS_QO = 366 * MiB, WS_K = 398 * MiB, WS_V = 430 * MiB;
constexpr size_t WS_ACT = 462 * MiB;
constexpr size_t WS_XS = 334 * MiB;
constexpr size_t WS_ACT2 = 590 * MiB;
constexpr size_t WS_END = 828 * MiB;
constexpr int CW_TMO = 0, CW_CODE = 1, CW_BAR = 4096, CW_CNT = 16384;
constexpr int RING_OFF = 0, RING_BYTES = 131072;
constexpr int LDSCTL_OFF = RING_BYTES, MISC_OFF = LDSCTL_OFF + 320;
constexpr int TAB_OFF = MISC_OFF + 128;
constexpr int RT_OFF = TAB_OFF + 128;
constexpr int LDS_BYTES = 147456;
static_assert(RT_OFF + 128 <= LDS_BYTES, "LDS map");

#define GAS __attribute__((address_space(1)))
#define LAS __attribute__((address_space(3)))
typedef unsigned short bf16;
typedef unsigned v4u __attribute__((ext_vector_type(4)));
typedef float f32x4 __attribute__((ext_vector_type(4)));
typedef short bf16x8 __attribute__((ext_vector_type(8)));
typedef GAS unsigned gu32;
typedef GAS unsigned long long gu64;
#define RLX_AGENT __ATOMIC_RELAXED, __HIP_MEMORY_SCOPE_AGENT
#define LDS_WAIT() asm volatile("s_waitcnt lgkmcnt(0)" ::: "memory")
#define VM_WAIT() asm volatile("s_waitcnt vmcnt(0)" ::: "memory")
__device__ __forceinline__ unsigned long long rt() { return __builtin_amdgcn_s_memrealtime(); }
__device__ __forceinline__ unsigned f2bf(float f) { unsigned u = __builtin_bit_cast(unsigned, f); return (u + 0x7fffu + ((u >> 16) & 1u)) >> 16; }
__device__ __forceinline__ unsigned pk2(float lo, float hi) { return f2bf(lo) | (f2bf(hi) << 16); }
#define XB_TMO      128
#define XB_XCNT(j)  (256  + 64 * (j))
#define XB_XSUB(j)  (1280 + 64 * (j))
#define XB_XGEN(j)  (2304 + 64 * (j))
#define XB_TOP      3328
#define XB_TOPGEN   3392
#define XCD_BAR_WORDS 3456
#define XB_SPIN_CAP (1u << 18)

__device__ __forceinline__ unsigned xb_ld(unsigned* p)              { return __hip_atomic_load(p, __ATOMIC_RELAXED, __HIP_MEMORY_SCOPE_AGENT); }
__device__ __forceinline__ unsigned xb_add(unsigned* p, unsigned v) { return __hip_atomic_fetch_add(p, v, __ATOMIC_RELAXED, __HIP_MEMORY_SCOPE_AGENT); }
__device__ __forceinline__ unsigned xb_xcc_id() { return (unsigned)__builtin_amdgcn_s_getreg((3 << 11) | 20) & 0xFu; }
#define XB_SPIN(cond, bar) do { unsigned _sp = 0; while (cond) { __builtin_amdgcn_s_sleep(1); \
    if ((++_sp & 255u) == 0u) { if (xb_ld(&(bar)[XB_TMO])) break; if (_sp > XB_SPIN_CAP) { atomicAdd(&(bar)[XB_TMO], 1u); break; } } } } while (0)

struct XcdBarrier {
    unsigned* bar; unsigned x;
    volatile LAS unsigned* st;
};

__device__ __forceinline__ XcdBarrier xcd_barrier_post(unsigned* bar, volatile LAS unsigned* st, const bool xb_leader) {
    XcdBarrier b; b.bar = bar; b.x = xb_xcc_id(); b.st = st;
    if (xb_leader) (void)xb_add(&bar[XB_XCNT(b.x)], 1u);
    return b;
}
__device__ __forceinline__ void xcd_barrier_complete(unsigned* bar, unsigned x, unsigned& nloc, unsigned& nx) {
    const unsigned G = gridDim.x * gridDim.y * gridDim.z;
    unsigned sum, cnt, mine, sp = 0u;
    for (;;) {
        sum = 0u; cnt = 0u; mine = 0u;
#pragma unroll
        for (unsigned j = 0; j < 16; ++j) { const unsigned c = xb_ld(&bar[XB_XCNT(j)]); sum += c; cnt += (c > 0u) ? 1u : 0u; mine = (j == x) ? c : mine; }
        if (sum == G) break;
        __builtin_amdgcn_s_sleep(1);
        if ((++sp & 255u) == 0u) { if (xb_ld(&bar[XB_TMO])) break; if (sp > XB_SPIN_CAP) { atomicAdd(&bar[XB_TMO], 1u); break; } }
    }
    nloc = mine > 0u ? mine : 1u; nx = cnt > 0u ? cnt : 1u;
}

__device__ __forceinline__ void xcd_barrier(const XcdBarrier& b, const bool xb_leader) {
    asm volatile("s_waitcnt vmcnt(0)" ::: "memory");
    __syncthreads();
    if (xb_leader) {
        unsigned* bar = b.bar;
        __builtin_amdgcn_s_waitcnt(0);
        unsigned nloc = b.st[0], nx = b.st[1];
        if (nloc == 0u) { xcd_barrier_complete(bar, b.x, nloc, nx); b.st[0] = nloc; b.st[1] = nx; }
        const unsigned old = xb_add(&bar[XB_XSUB(b.x)], 1u);
        const unsigned gen = old / nloc;
        if (old + 1u == (gen + 1u) * nloc) {
            __builtin_amdgcn_fence(__ATOMIC_RELEASE, "agent");
            asm volatile("s_waitcnt vmcnt(0)" ::: "memory");
            const unsigned og = xb_add(&bar[XB_TOP], 1u);
            const unsigned tg = og / nx;
            if (og + 1u == (tg + 1u) * nx) xb_add(&bar[XB_TOPGEN], 1u);
            else XB_SPIN(xb_ld(&bar[XB_TOPGEN]) == tg, bar);
            __builtin_amdgcn_fence(__ATOMIC_ACQUIRE, "agent");
            xb_add(&bar[XB_XGEN(b.x)], 1u);
            asm volatile("s_waitcnt vmcnt(0)" ::: "memory");
        } else {
            XB_SPIN(xb_ld(&bar[XB_XGEN(b.x)]) == gen, bar);
            __builtin_amdgcn_fence(__ATOMIC_ACQUIRE, "agent");
            asm volatile("s_waitcnt vmcnt(0)" ::: "memory");
        }
    }
    __syncthreads();
}

struct Frame {
    LAS unsigned char* lds;
    volatile LAS unsigned* MISC;
    gu32* ctl;
    unsigned char* ws;
    int wave;
    int vcu, G;
};
struct Args { const float* in[20]; float* out; unsigned char* ws; int ph_lo, ph_hi; };

__device__ __forceinline__ float wave_sum(float v) {
#pragma unroll
    for (int o = 1; o < 64; o <<= 1) v += __shfl_xor(v, o);
    return v;
}
__device__ __forceinline__ float bf_lo(unsigned w) { return __uint_as_float(w << 16); }
__device__ __forceinline__ float bf_hi(unsigned w) { return __uint_as_float(w & 0xffff0000u); }

__device__ __forceinline__ void tr_item(const float* W, int ld, int K, int nblk, int item, bf16* WT, bool gu, LAS float* scr, int lane) {
    const int kb = item / nblk, nb = item % nblk, k0 = 64 * kb, n0 = 32 * nb;
    int drow0 = n0;
    if (gu) { const int bj = n0 / FF, j = n0 - bj * FF; drow0 = 256 * (j / 128) + 128 * bj + (j % 128); }
#pragma unroll 8
    for (int i = 0; i < 32; ++i) { const int kk = 2 * i + (lane >> 5); scr[kk * 33 + (lane & 31)] = W[(size_t)(k0 + kk) * ld + n0 + (lane & 31)]; }
    LDS_WAIT(); asm volatile("" ::: "memory");
    const int c = lane & 7;
#pragma unroll
    for (int j = 0; j < 4; ++j) { const int n = (lane >> 3) + 8 * j; const LAS float* s = scr + (8 * c) * 33 + n;
        v4u o; o.x = pk2(s[0 * 33], s[1 * 33]); o.y = pk2(s[2 * 33], s[3 * 33]); o.z = pk2(s[4 * 33], s[5 * 33]); o.w = pk2(s[6 * 33], s[7 * 33]);
        *(GAS v4u*)(WT + (size_t)(drow0 + n) * K + k0 + 8 * c) = o; }
    LDS_WAIT(); asm volatile("" ::: "memory");
}
__device__ __forceinline__ void p0_prologue(Frame& F, const Args& a) {
    const int lane = pg8::pg8_lane_id(), tid = F.wave * 64 + lane; (void)tid;
    const float* c_in = a.in[1]; const float* w_ada = a.in[2]; const float* b_ada = a.in[3];
    float* MOD = (float*)(F.ws + WS_MOD);
    LAS float* sc = (LAS float*)(F.lds + RING_OFF + 96 * 1024);
    LAS float* red = (LAS float*)(F.lds + RING_OFF + 112 * 1024);
    for (int i = tid; i < NB * D; i += NWAVES * 64) { const float v = c_in[i]; sc[i] = v / (1.f + __expf(-v)); }
    __syncthreads();
    for (int item = blockIdx.x; item < 2 * (NMOD / 32); item += F.G) {
        const int l = item / (NMOD / 32), n0 = (item % (NMOD / 32)) * 32, col = lane & 31, kpar = lane >> 5;
        const float* wp = w_ada + (size_t)l * D * NMOD + n0 + col;
        float a0 = 0.f, a1 = 0.f, a2 = 0.f, a3 = 0.f;
#pragma unroll 8
        for (int i = 0; i < 64; ++i) { const int k = 128 * F.wave + 2 * i + kpar; const float wv = wp[(size_t)k * NMOD];
            a0 += sc[k] * wv; a1 += sc[D + k] * wv; a2 += sc[2 * D + k] * wv; a3 += sc[3 * D + k] * wv; }
        a0 += __shfl_xor(a0, 32); a1 += __shfl_xor(a1, 32); a2 += __shfl_xor(a2, 32); a3 += __shfl_xor(a3, 32);
        if (lane < 32) { red[(F.wave * 4 + 0) * 32 + col] = a0; red[(F.wave * 4 + 1) * 32 + col] = a1; red[(F.wave * 4 + 2) * 32 + col] = a2; red[(F.wave * 4 + 3) * 32 + col] = a3; }
        __syncthreads();
        if (tid < 128) { const int b = tid >> 5, cc = tid & 31; float s = 0.f;
#pragma unroll
            for (int w = 0; w < 8; ++w) s += red[(w * 4 + b) * 32 + cc];
            MOD[(size_t)(l * NB + b) * NMOD + n0 + cc] = s + b_ada[l * NMOD + n0 + cc]; }
        __syncthreads();
    }
    { bf16* WFT = (bf16*)(F.ws + WS_WFT); const float* w = a.in[7];
      for (int i = blockIdx.x * (NWAVES * 64) + tid; i < 16 * D; i += F.G * NWAVES * 64) { const int hh = i & 15, k = i >> 4; WFT[hh * D + k] = (bf16)f2bf(w[(size_t)k * (3 * D + 16) + 3 * D + hh]); } }
    LAS float* scr = (LAS float*)(F.lds + RING_OFF + F.wave * 8448);
    const int gw = F.vcu * NWAVES + F.wave, NGW = F.G * NWAVES;
    constexpr int I_FI = 16 * 96, I_FO = 16 * 32, I_SI = 16 * 48, I_SO = 16 * 32, I_GU = 16 * 224, I_DN = 56 * 32;
    constexpr int NITEMS = I_FI + I_FO + I_SI + I_SO + I_GU + I_DN + NE * (I_GU + I_DN);
    for (int it = gw; it < NITEMS; it += NGW) {
        int r = it;
        if (r < I_FI) { tr_item(a.in[7], 3 * D + 16, D, 96, r, (bf16*)(F.ws + WS_WFOXIN), false, scr, lane); continue; } r -= I_FI;
        if (r < I_FO) { tr_item(a.in[9], D, D, 32, r, (bf16*)(F.ws + WS_WFOXOUT), false, scr, lane); continue; } r -= I_FO;
        if (r < I_SI) { tr_item(a.in[10], D + 512, D, 48, r, (bf16*)(F.ws + WS_WSWAIN), false, scr, lane); continue; } r -= I_SI;
        if (r < I_SO) { tr_item(a.in[12], D, D, 32, r, (bf16*)(F.ws + WS_WSWAOUT), false, scr, lane); continue; } r -= I_SO;
        if (r < I_GU) { tr_item(a.in[14], 2 * FF, D, 224, r, (bf16*)(F.ws + WS_WGU), true, scr, lane); continue; } r -= I_GU;
        if (r < I_DN) { tr_item(a.in[15], D, FF, 32, r, (bf16*)(F.ws + WS_WDN), false, scr, lane); continue; } r -= I_DN;
        if (r < NE * I_GU) { const int e = r / I_GU, rr = r % I_GU; tr_item(a.in[18] + (size_t)e * D * 2 * FF, 2 * FF, D, 224, rr, (bf16*)(F.ws + WS_WMGU) + (size_t)e * 2 * FF * D, true, scr, lane); continue; } r -= NE * I_GU;
        { const int e = r / I_DN, rr = r % I_DN; tr_item(a.in[19] + (size_t)e * FF * D, D, FF, 32, rr, (bf16*)(F.ws + WS_WMDN) + (size_t)e * D * FF, false, scr, lane); }
    }
}

__device__ __forceinline__ void norm_mod_rows(Frame& F, const float* xin, const float* g, const float* shift, const float* scale, bf16* XN) {
    const int lane = pg8::pg8_lane_id(), tid = F.wave * 64 + lane; (void)tid;
    const int gw = F.vcu * NWAVES + F.wave, NGW = F.G * NWAVES;
    for (int rg = gw; rg < M / 8; rg += NGW) {
        const int row0 = rg * 8, b = row0 / S;
        f32x4 gs[4], sh[4];
#pragma unroll
        for (int j = 0; j < 4; ++j) { const f32x4 gv = ((const GAS f32x4*)g)[lane + 64 * j], sv = ((const GAS f32x4*)(scale + (size_t)b * NMOD))[lane + 64 * j];
            gs[j] = gv * (sv + 1.0f); sh[j] = ((const GAS f32x4*)(shift + (size_t)b * NMOD))[lane + 64 * j]; }
#pragma unroll 2
        for (int r = 0; r < 8; ++r) {
            const GAS f32x4* xr = (const GAS f32x4*)(xin + (size_t)(row0 + r) * D) + lane;
            f32x4 v[4]; float s = 0.f;
#pragma unroll
            for (int j = 0; j < 4; ++j) { v[j] = xr[64 * j]; s += (v[j].x * v[j].x + v[j].y * v[j].y) + (v[j].z * v[j].z + v[j].w * v[j].w); }
            const float rstd = rsqrtf(wave_sum(s) * (1.f / D) + RMS_EPS);
            GAS unsigned long long* o8 = (GAS unsigned long long*)(XN + (size_t)(row0 + r) * D) + lane;
#pragma unroll
            for (int j = 0; j < 4; ++j) { const f32x4 y = v[j] * rstd * gs[j] + sh[j];
                o8[64 * j] = (unsigned long long)pg8::cvt_pk_bf16(y.x, y.y) | ((unsigned long long)pg8::cvt_pk_bf16(y.z, y.w) << 32); }
        }
    }
}
__device__ __forceinline__ void fgate_groups(Frame& F, const bf16* XN, const bf16* WFT, const float* b_f, float* LOGFT) {
    const int lane = pg8::pg8_lane_id(), tid = F.wave * 64 + lane; (void)tid;
    const int gw = F.vcu * NWAVES + F.wave, NGW = F.G * NWAVES, fr = lane & 15, fq = lane >> 4;
    for (int grp = gw; grp < M / 16; grp += NGW) {
        const int row0 = grp * 16;
        const bf16* ap = XN + (size_t)(row0 + fr) * D + 8 * fq; const bf16* wp = WFT + (size_t)fr * D + 8 * fq;
        f32x4 acc = (f32x4){0.f, 0.f, 0.f, 0.f};
#pragma unroll 8
        for (int kk = 0; kk < 32; ++kk) { const bf16x8 xv = *(const GAS bf16x8*)(ap + 32 * kk), wv = *(const GAS bf16x8*)(wp + 32 * kk);
            acc = __builtin_amdgcn_mfma_f32_16x16x32_bf16(wv, xv, acc, 0, 0, 0); }
        const int row = row0 + fr, b = row / S, s = row % S;
#pragma unroll
        for (int r = 0; r < 4; ++r) { const int hh = 4 * fq + r; const float z = acc[r] + b_f[hh];
            const float ls = fminf(z, 0.f) - log1pf(__expf(-fabsf(z)));
            LOGFT[(size_t)(b * NH + hh) * S + s] = ls * LOG2E; }
    }
}
__device__ __forceinline__ void block_scan4096(Frame& F, const float* src, LAS float* cum, LAS float* part) {
    const int lane = pg8::pg8_lane_id(), tid = F.wave * 64 + lane; (void)tid;
    const GAS f32x4* p = (const GAS f32x4*)src + 2 * tid;
    const f32x4 a = p[0], b = p[1];
    float v[8]; v[0] = a.x; v[1] = v[0] + a.y; v[2] = v[1] + a.z; v[3] = v[2] + a.w; v[4] = v[3] + b.x; v[5] = v[4] + b.y; v[6] = v[5] + b.z; v[7] = v[6] + b.w;
    float incl = v[7];
#pragma unroll
    for (int o = 1; o < 64; o <<= 1) { const float t = __shfl_up(incl, o); if (lane >= o) incl += t; }
    if (lane == 63) part[F.wave] = incl;
    __syncthreads();
    float base = incl - v[7];
#pragma unroll
    for (int w = 0; w < 8; ++w) if (w < F.wave) base += part[w];
#pragma unroll
    for (int i = 0; i < 8; ++i) cum[8 * tid + i] = v[i] + base;
    __syncthreads();
}
__device__ __forceinline__ void simple_attn_row_init(const bf16* qrow, unsigned (&q2)[32]) {
#pragma unroll
    for (int i = 0; i < 8; ++i) { const v4u t = *(const GAS v4u*)(qrow + 8 * i); q2[4 * i] = t.x; q2[4 * i + 1] = t.y; q2[4 * i + 2] = t.z; q2[4 * i + 3] = t.w; }
}
__device__ __forceinline__ void simple_kv_tile_load(const bf16* kbase, const bf16* vbase, size_t pitch, LAS unsigned char* reg, int lane) {
    const int key = lane >> 1, half = lane & 1;
#pragma unroll
    for (int i = 0; i < 4; ++i) { *(LAS v4u*)(reg + key * 128 + half * 64 + 16 * i) = *(const GAS v4u*)(kbase + (size_t)key * pitch + half * 32 + 8 * i);
        *(LAS v4u*)(reg + 4096 + key * 128 + half * 64 + 16 * i) = *(const GAS v4u*)(vbase + (size_t)key * pitch + half * 32 + 8 * i); }
    LDS_WAIT(); __builtin_amdgcn_wave_barrier(); asm volatile("" ::: "memory");
}
__device__ __forceinline__ float simple_dot(const unsigned (&q2)[32], const LAS unsigned char* krow) {
    float s = 0.f;
#pragma unroll
    for (int i = 0; i < 8; ++i) { const v4u t = *(const LAS v4u*)(krow + 16 * i);
        s += bf_lo(q2[4 * i]) * bf_lo(t.x) + bf_hi(q2[4 * i]) * bf_hi(t.x); s += bf_lo(q2[4 * i + 1]) * bf_lo(t.y) + bf_hi(q2[4 * i + 1]) * bf_hi(t.y);
        s += bf_lo(q2[4 * i + 2]) * bf_lo(t.z) + bf_hi(q2[4 * i + 2]) * bf_hi(t.z); s += bf_lo(q2[4 * i + 3]) * bf_lo(t.w) + bf_hi(q2[4 * i + 3]) * bf_hi(t.w); }
    return s;
}
__device__ __forceinline__ void simple_pv(float (&acc)[64], float al, float p, const LAS unsigned char* vrow) {
#pragma unroll
    for (int i = 0; i < 8; ++i) { const v4u t = *(const LAS v4u*)(vrow + 16 * i);
        acc[8 * i + 0] = acc[8 * i + 0] * al + p * bf_lo(t.x); acc[8 * i + 1] = acc[8 * i + 1] * al + p * bf_hi(t.x);
        acc[8 * i + 2] = acc[8 * i + 2] * al + p * bf_lo(t.y); acc[8 * i + 3] = acc[8 * i + 3] * al + p * bf_hi(t.y);
        acc[8 * i + 4] = acc[8 * i + 4] * al + p * bf_lo(t.z); acc[8 * i + 5] = acc[8 * i + 5] * al + p * bf_hi(t.z);
        acc[8 * i + 6] = acc[8 * i + 6] * al + p * bf_lo(t.w); acc[8 * i + 7] = acc[8 * i + 7] * al + p * bf_hi(t.w); }
}
__device__ __forceinline__ void simple_store_row(bf16* orow, const float (&acc)[64], float inv) {
#pragma unroll
    for (int i = 0; i < 8; ++i) { v4u t; t.x = pg8::cvt_pk_bf16(acc[8 * i] * inv, acc[8 * i + 1] * inv); t.y = pg8::cvt_pk_bf16(acc[8 * i + 2] * inv, acc[8 * i + 3] * inv);
        t.z = pg8::cvt_pk_bf16(acc[8 * i + 4] * inv, acc[8 * i + 5] * inv); t.w = pg8::cvt_pk_bf16(acc[8 * i + 6] * inv, acc[8 * i + 7] * inv); *(GAS v4u*)(orow + 8 * i) = t; }
}
__device__ __forceinline__ void fox_attn_simple(Frame& F, const bf16* Q, const bf16* K, const bf16* V, bf16* O, const float* LOGFT) {
    const int lane = pg8::pg8_lane_id(), tid = F.wave * 64 + lane; (void)tid;
    LAS float* cum = (LAS float*)(F.lds + RING_OFF + 65536); LAS float* part = (LAS float*)(F.lds + RING_OFF + 65536 + 16384);
    LAS unsigned char* reg = F.lds + RING_OFF + F.wave * 8192;
    for (int pb = F.vcu; pb < 256; pb += F.G) {
        const int bh = pb >> 2, b = bh / NH, h = bh % NH;
        block_scan4096(F, LOGFT + (size_t)bh * S, cum, part);
        const int j = (pb * 8 + F.wave) & 31;
        for (int which = 0; which < 2; ++which) {
            const int qt = which ? 63 - j : j, row = qt * 64 + lane;
            unsigned q2[32]; simple_attn_row_init(Q + (size_t)(b * S + row) * D + h * 64, q2);
            float acc[64];
#pragma unroll
            for (int d = 0; d < 64; ++d) acc[d] = 0.f;
            float m = -INFINITY, l = 0.f; const float cq = cum[row];
            for (int kt = 0; kt < 2 * qt + 2; ++kt) {
                __builtin_amdgcn_wave_barrier(); asm volatile("" ::: "memory");
                simple_kv_tile_load(K + (size_t)(b * S + kt * 32) * D + h * 64, V + (size_t)(b * S + kt * 32) * D + h * 64, D, reg, lane);
                for (int jj = 0; jj < 32; ++jj) { const int key = kt * 32 + jj;
                    const float s = simple_dot(q2, reg + jj * 128) + cq - cum[key];
                    if (key <= row) { const float mn = fmaxf(m, s), al = __builtin_amdgcn_exp2f(m - mn), p = __builtin_amdgcn_exp2f(s - mn); l = l * al + p; m = mn; simple_pv(acc, al, p, reg + 4096 + jj * 128); } }
            }
            simple_store_row(O + (size_t)(b * S + row) * D + h * 64, acc, 1.f / l);
        }
        __syncthreads();
    }
}
__device__ __forceinline__ int t5_bucket(int rel) {
    const int n = rel < 0 ? -rel : rel;
    const int v = n < 8 ? n : 8 + (n >= 12) + (n >= 16) + (n >= 23) + (n >= 32) + (n >= 46) + (n >= 64) + (n >= 91);
    return (rel > 0 ? 16 : 0) + v;
}
__device__ __forceinline__ void swa_unit(int b, int c, int hk, const attn_body::bf16* Q, const attn_body::bf16* K2, const attn_body::bf16* V2, attn_body::bf16* O, char* shm, attn_body::lds_cfptr tbl, const float* sinks, const int wid) {
    using namespace attn_body; typedef attn_body::bf16 abf;
    const int lane = pg8::pg8_lane_id(), r32 = lane & 31, hi = lane >> 5;
    const int hq = hk * 4 + (wid >> 1), qi = (wid & 1) * 32 + r32;
    const long rowq = (long)b * SEQ + c * 64;
    const abf* Qw = Q + (rowq + (wid & 1) * 32) * DM + hq * 64;
    const unsigned lds0 = (unsigned)(uintptr_t)shm;
    const int j0 = c >= 2 ? 0 : 2 - c;
#pragma unroll
    for (int j = 0; j < 3; ++j) if (j >= j0) {
        const long pos0 = (long)b * SEQ + c * 64 - 128 + 64 * j;
        glds16(K2 + (pos0 + lane) * 256 + hk * 64 + wid * 8, (unsigned)__builtin_amdgcn_readfirstlane(lds0 + LDS_K + j * SLOTB + wid * 1024));
        glds16(V2 + (pos0 + 16 * (wid & 3) + (lane >> 2)) * 256 + hk * 64 + (wid >> 2) * 32 + (lane & 3) * 8, (unsigned)__builtin_amdgcn_readfirstlane(lds0 + LDS_V + j * SLOTB + wid * 1024));
    }
    bf16x8 qr[4];
#pragma unroll
    for (int d0 = 0; d0 < 4; ++d0) qr[d0] = *reinterpret_cast<const bf16x8*>(&Qw[(long)r32 * DM + d0 * 16 + hi * 8]);
    const float sk = sinks[hq] * 1.4426950408889634f;
    asm volatile("s_waitcnt vmcnt(0) lgkmcnt(0)\n\ts_barrier" ::: "memory");
    f32x16 sc[3][2];
    const lds_cfptr tb = tbl + hq * 256 + 63 - qi + 4 * hi;
#pragma unroll
    for (int j = 0; j < 3; ++j) if (j >= j0) {
#pragma unroll
        for (int r = 0; r < 16; ++r) { const int ko = 64 * j + (r & 3) + 8 * (r >> 2); sc[j][0][r] = tb[ko]; sc[j][1][r] = tb[ko + 32]; }
        qkt(sc[j][0], sc[j][1], shm + LDS_K + j * SLOTB, qr, r32, hi);
    }
    float m = sk;
#pragma unroll
    for (int j = 0; j < 3; ++j) if (j >= j0) {
#pragma unroll
        for (int r = 0; r < 16; ++r) m = __builtin_fmaxf(m, __builtin_fmaxf(sc[j][0][r], sc[j][1][r]));
    }
    { auto rr = __builtin_amdgcn_permlane32_swap(__float_as_uint(m), __float_as_uint(m), false, false); m = __builtin_fmaxf(__uint_as_float(rr[0]), __uint_as_float(rr[1])); }
    float l = 0.f; f32x16 o[2]; o[0] = f32x16{}; o[1] = f32x16{};
    const int vb0 = (int)(lds0 + LDS_V) + ((lane >> 4) & 1) * 32 + (lane & 3) * 8 + (4 * hi + ((lane & 15) >> 2)) * 64;
#pragma unroll
    for (int j = 0; j < 3; ++j) if (j >= j0) {
#pragma unroll
        for (int r = 0; r < 16; ++r) { sc[j][0][r] = __builtin_amdgcn_exp2f(sc[j][0][r] - m); sc[j][1][r] = __builtin_amdgcn_exp2f(sc[j][1][r] - m); l += sc[j][0][r] + sc[j][1][r]; }
        u32x4 pw0, pw1, pw2, pw3;
#define SWA_PK(P, B) cvtpk_s(P[B], P[B + 1])
        pw0 = (u32x4){SWA_PK(sc[j][0], 0), SWA_PK(sc[j][0], 2), SWA_PK(sc[j][0], 4), SWA_PK(sc[j][0], 6)}; pw1 = (u32x4){SWA_PK(sc[j][0], 8), SWA_PK(sc[j][0], 10), SWA_PK(sc[j][0], 12), SWA_PK(sc[j][0], 14)};
        pw2 = (u32x4){SWA_PK(sc[j][1], 0), SWA_PK(sc[j][1], 2), SWA_PK(sc[j][1], 4), SWA_PK(sc[j][1], 6)}; pw3 = (u32x4){SWA_PK(sc[j][1], 8), SWA_PK(sc[j][1], 10), SWA_PK(sc[j][1], 12), SWA_PK(sc[j][1], 14)};
#undef SWA_PK
        pv(o, vb0 + j * SLOTB, __builtin_bit_cast(bf16x8, pw0), __builtin_bit_cast(bf16x8, pw1), __builtin_bit_cast(bf16x8, pw2), __builtin_bit_cast(bf16x8, pw3));
    }
    { auto rr = __builtin_amdgcn_permlane32_swap(__float_as_uint(l), __float_as_uint(l), false, false); l = __uint_as_float(rr[0]) + __uint_as_float(rr[1]); }
    l += __builtin_amdgcn_exp2f(sk - m);
    float* wsf = (float*)(shm + LDS_WS) + wid * 64;
    if (hi == 0) wsf[32 + r32] = l; asm volatile("s_waitcnt lgkmcnt(0)" ::: "memory");
    float rli[16];
#pragma unroll
    for (int r = 0; r < 16; ++r) rli[r] = __builtin_amdgcn_rcpf(wsf[32 + crow(r, hi)]);
    abf* Ow = O + (rowq + (wid & 1) * 32) * DM + hq * 64;
    { abf* stg = (abf*)(shm + LDS_OST) + wid * 2048;
#pragma unroll
        for (int r = 0; r < 16; ++r) { const int orow = crow(r, hi);
#pragma unroll
            for (int d0 = 0; d0 < 2; ++d0) stg[orow * 64 + d0 * 32 + r32] = __float2bfloat16(o[d0][r] * rli[r]); }
        asm volatile("s_waitcnt lgkmcnt(0)" ::: "memory");
#pragma unroll
        for (int i = 0; i < 4; ++i) { const int row = i * 8 + (lane >> 3), ch = lane & 7; const u32x4 v = *(const u32x4*)(stg + row * 64 + ch * 8); *(u32x4*)(Ow + (long)row * DM + ch * 8) = v; } }
    asm volatile("s_waitcnt lgkmcnt(0)\n\ts_barrier" ::: "memory");
}
__device__ __forceinline__ void swa_phase(char* lds, const bf16* Q, const bf16* K2, const bf16* V2, bf16* O, const float* sinks, const float* rel_bias, LAS float* tbl, int v, int G, const int wid) {
    { const int lane = pg8::pg8_lane_id(), tid = wid * 64 + lane;
      for (int i = tid; i < 16 * 256; i += NWAVES * 64) { const int hq = i >> 8, k = i & 255; tbl[i] = (k < 255) ? rel_bias[t5_bucket(k - 191) * NH + hq] * LOG2E : 0.f; } }
    __syncthreads();
    for (int item = v; item < 256; item += G) {
        const int b = item >> 6, hk = (item >> 4) & 3, c0 = (item & 15) * 4;
#pragma unroll 1
        for (int i = 0; i < 4; ++i) swa_unit(b, c0 + i, hk, (const attn_body::bf16*)Q, (const attn_body::bf16*)K2, (const attn_body::bf16*)V2, (attn_body::bf16*)O, lds, (attn_body::lds_cfptr)tbl, sinks, wid);
    }
    __syncthreads();
}
__device__ __forceinline__ void swa_attn_simple(Frame& F, const bf16* Q, const bf16* K, const bf16* V, bf16* O, const float* sinks, const float* rel_bias) {
    const int lane = pg8::pg8_lane_id(), tid = F.wave * 64 + lane; (void)tid;
    LAS unsigned char* reg = F.lds + RING_OFF + F.wave * 8192;
    LAS float* T = (LAS float*)(F.lds + RING_OFF + 65536 + F.wave * 1024);
    const int gw = F.vcu * NWAVES + F.wave, NGW = F.G * NWAVES;
    for (int ui = gw; ui < NB * 64 * NH; ui += NGW) {
        const int hq = ui % NH, c = (ui / NH) % 64, b = ui / (NH * 64), hk = hq >> 2, row = c * 64 + lane;
        __builtin_amdgcn_wave_barrier(); asm volatile("" ::: "memory");
        for (int i = lane; i < 255; i += 64) T[i] = rel_bias[t5_bucket(i - 191) * NH + hq] * LOG2E;
        unsigned q2[32]; simple_attn_row_init(Q + (size_t)(b * S + row) * D + hq * 64, q2);
        float acc[64];
#pragma unroll
        for (int d = 0; d < 64; ++d) acc[d] = 0.f;
        float m = -INFINITY, l = 0.f;
        for (int kt = 0; kt < 6; ++kt) {
            const int pos0 = 64 * c - 128 + 32 * kt; if (pos0 < 0) continue;
            __builtin_amdgcn_wave_barrier(); asm volatile("" ::: "memory");
            simple_kv_tile_load(K + (size_t)(b * S + pos0) * 256 + hk * 64, V + (size_t)(b * S + pos0) * 256 + hk * 64, 256, reg, lane);
            for (int jj = 0; jj < 32; ++jj) { const int kb = 32 * kt + jj;
                const float s = simple_dot(q2, reg + jj * 128) + T[kb + 63 - lane];
                const float mn = fmaxf(m, s), al = __builtin_amdgcn_exp2f(m - mn), p = __builtin_amdgcn_exp2f(s - mn); l = l * al + p; m = mn; simple_pv(acc, al, p, reg + 4096 + jj * 128); }
        }
        const float sk = sinks[hq] * LOG2E, mf = fmaxf(m, sk), al = __builtin_amdgcn_exp2f(m - mf);
        l = l * al + __builtin_amdgcn_exp2f(sk - mf);
        simple_store_row(O + (size_t)(b * S + row) * D + hq * 64, acc, al / l);
    }
}
__device__ __forceinline__ void route_rows(Frame& F, const float* xin, const float* g, const float* shift, const float* scale, const float* w_router, const float* b_router,
                                           bf16* XS, int* list, float* wl, gu32* cnt) {
    const int lane = pg8::pg8_lane_id(), tid = F.wave * 64 + lane; (void)tid;
    LAS float* wr = (LAS float*)(F.lds + RING_OFF);
    volatile LAS int* rt = (volatile LAS int*)(F.lds + RT_OFF);
    for (int i = tid; i < D * NE; i += NWAVES * 64) wr[i] = w_router[i];
    for (int blk = F.vcu; blk < M / 32; blk += F.G) {
        if (tid < 16) rt[tid] = 0;
        __syncthreads();
        const int row0 = blk * 32 + F.wave * 4, b = row0 / S;
        f32x4 gs[4], sh[4];
#pragma unroll
        for (int j = 0; j < 4; ++j) { const f32x4 gv = ((const GAS f32x4*)g)[lane + 64 * j], sv = ((const GAS f32x4*)(scale + (size_t)b * NMOD))[lane + 64 * j];
            gs[j] = gv * (sv + 1.0f); sh[j] = ((const GAS f32x4*)(shift + (size_t)b * NMOD))[lane + 64 * j]; }
        unsigned hp[4][8]; int e0[4], e1[4], p0[4], p1[4]; float w0[4];
#pragma unroll
        for (int r = 0; r < 4; ++r) {
            const GAS f32x4* xr = (const GAS f32x4*)(xin + (size_t)(row0 + r) * D) + lane;
            f32x4 v[4]; float s = 0.f;
#pragma unroll
            for (int j = 0; j < 4; ++j) { v[j] = xr[64 * j]; s += (v[j].x * v[j].x + v[j].y * v[j].y) + (v[j].z * v[j].z + v[j].w * v[j].w); }
            const float rstd = rsqrtf(wave_sum(s) * (1.f / D) + RMS_EPS);
            float lg[8];
#pragma unroll
            for (int e = 0; e < 8; ++e) lg[e] = 0.f;
#pragma unroll
            for (int j = 0; j < 4; ++j) { const f32x4 y = v[j] * rstd * gs[j] + sh[j];
                hp[r][2 * j] = pg8::cvt_pk_bf16(y.x, y.y); hp[r][2 * j + 1] = pg8::cvt_pk_bf16(y.z, y.w);
#pragma unroll
                for (int i = 0; i < 4; ++i) { const LAS f32x4* wq = (const LAS f32x4*)(wr + (size_t)(4 * lane + 256 * j + i) * 8); const f32x4 wa = wq[0], wb = wq[1]; const float yv = y[i];
                    lg[0] += yv * wa.x; lg[1] += yv * wa.y; lg[2] += yv * wa.z; lg[3] += yv * wa.w; lg[4] += yv * wb.x; lg[5] += yv * wb.y; lg[6] += yv * wb.z; lg[7] += yv * wb.w; } }
#pragma unroll
            for (int e = 0; e < 8; ++e) lg[e] = wave_sum(lg[e]) + b_router[e];
            int i0 = 0; float v0 = lg[0];
#pragma unroll
            for (int e = 1; e < 8; ++e) if (lg[e] > v0) { v0 = lg[e]; i0 = e; }
            int i1 = 0; float v1 = -INFINITY;
#pragma unroll
            for (int e = 0; e < 8; ++e) if (e != i0 && lg[e] > v1) { v1 = lg[e]; i1 = e; }
            const float wt1 = 1.f / (1.f + __expf(v0 - v1));
            e0[r] = i0; e1[r] = i1; w0[r] = 1.f - wt1;
            int q0 = 0, q1 = 0;
            if (lane == 0) { q0 = __hip_atomic_fetch_add((LAS int*)rt + i0, 1, __ATOMIC_RELAXED, __HIP_MEMORY_SCOPE_WORKGROUP); q1 = __hip_atomic_fetch_add((LAS int*)rt + i1, 1, __ATOMIC_RELAXED, __HIP_MEMORY_SCOPE_WORKGROUP); }
            p0[r] = __builtin_amdgcn_readfirstlane(q0); p1[r] = __builtin_amdgcn_readfirstlane(q1);
        }
        __syncthreads();
        if (tid < 8) rt[8 + tid] = (int)__hip_atomic_fetch_add(cnt + 64 * tid, (unsigned)rt[tid], __ATOMIC_RELAXED, __HIP_MEMORY_SCOPE_AGENT);
        __syncthreads();
#pragma unroll
        for (int r = 0; r < 4; ++r) {
            const int tok = row0 + r;
            const int d0 = e0[r] * ECAP + rt[8 + e0[r]] + p0[r], d1 = e1[r] * ECAP + rt[8 + e1[r]] + p1[r];
            GAS unsigned long long* o0 = (GAS unsigned long long*)(XS + (size_t)d0 * D) + lane; GAS unsigned long long* o1 = (GAS unsigned long long*)(XS + (size_t)d1 * D) + lane;
#pragma unroll
            for (int j = 0; j < 4; ++j) { const unsigned long long pk = (unsigned long long)hp[r][2 * j] | ((unsigned long long)hp[r][2 * j + 1] << 32); o0[64 * j] = pk; o1[64 * j] = pk; }
            if (lane == 0) { list[d0] = 2 * tok; wl[d0] = w0[r]; list[d1] = 2 * tok + 1; wl[d1] = 1.f - w0[r]; }
        }
        __syncthreads();
    }
}
__device__ __forceinline__ void final_rows(Frame& F, const float* XA, const bf16* YS, const float* gate, const float* g, float* out) {
    const int lane = pg8::pg8_lane_id(), tid = F.wave * 64 + lane; (void)tid;
    const int gw = F.vcu * NWAVES + F.wave, NGW = F.G * NWAVES;
    for (int rg = gw; rg < M / 8; rg += NGW) {
        const int row0 = rg * 8, b = row0 / S;
        f32x4 gt[4], gf[4];
#pragma unroll
        for (int j = 0; j < 4; ++j) { gt[j] = ((const GAS f32x4*)(gate + (size_t)b * NMOD))[lane + 64 * j]; gf[j] = ((const GAS f32x4*)g)[lane + 64 * j]; }
#pragma unroll 2
        for (int r = 0; r < 8; ++r) {
            const int row = row0 + r;
            const GAS f32x4* xr = (const GAS f32x4*)(XA + (size_t)row * D) + lane;
            const GAS unsigned long long* y0 = (const GAS unsigned long long*)(YS + (size_t)(2 * row) * D) + lane; const GAS unsigned long long* y1 = (const GAS unsigned long long*)(YS + (size_t)(2 * row + 1) * D) + lane;
            f32x4 v[4]; float s = 0.f;
#pragma unroll
            for (int j = 0; j < 4; ++j) { const unsigned long long a = y0[64 * j], c = y1[64 * j]; const unsigned al = (unsigned)a, ah = (unsigned)(a >> 32), cl = (unsigned)c, ch = (unsigned)(c >> 32);
                const f32x4 ys = (f32x4){bf_lo(al) + bf_lo(cl), bf_hi(al) + bf_hi(cl), bf_lo(ah) + bf_lo(ch), bf_hi(ah) + bf_hi(ch)};
                v[j] = xr[64 * j] + gt[j] * ys; s += (v[j].x * v[j].x + v[j].y * v[j].y) + (v[j].z * v[j].z + v[j].w * v[j].w); }
            const float rstd = rsqrtf(wave_sum(s) * (1.f / D) + RMS_EPS);
            GAS f32x4* o = (GAS f32x4*)(out + (size_t)row * D) + lane;
#pragma unroll
            for (int j = 0; j < 4; ++j) o[64 * j] = v[j] * rstd * gf[j];
        }
    }
}

__global__ void __launch_bounds__(NWAVES * 64, 2) mk_fwd(Args args) {
    extern __shared__ __attribute__((aligned(16))) unsigned char lds[];
    Frame F;
    F.lds = (LAS unsigned char*)lds;
    F.MISC = (volatile LAS unsigned*)(F.lds + MISC_OFF);
    F.wave = __builtin_amdgcn_readfirstlane((int)threadIdx.x >> 6);
    F.G = gridDim.x; { const int bx = blockIdx.x; F.vcu = (F.G % 8 == 0) ? (bx % 8) * (F.G / 8) + bx / 8 : bx; }
    F.ws = args.ws; F.ctl = (gu32*)(args.ws + WS_CTL);
    for (int u = F.wave * 64 + pg8::pg8_lane_id(); u < (LDS_BYTES - LDSCTL_OFF) / 4; u += NWAVES * 64) ((LAS unsigned*)(F.lds + LDSCTL_OFF))[u] = 0u;
    __syncthreads();
    XcdBarrier bar = xcd_barrier_post((unsigned*)(F.ctl + CW_BAR), F.MISC + 8, F.wave == 0 && pg8::pg8_lane_id() == 0);
    const int lo = args.ph_lo, hi = args.ph_hi;
#define IN(k) (lo <= (k) && (k) < hi)
#define SEAM(k) do { if (IN(k) && IN((k) + 1)) xcd_barrier(bar, F.wave == 0 && pg8::pg8_lane_id() == 0); } while (0)
    unsigned char* ws = args.ws;
    const float* MOD0 = (const float*)(ws + WS_MOD); const float* MOD1 = MOD0 + NB * NMOD;
    bf16* XN = (bf16*)(ws + WS_XN); bf16* QO = (bf16*)(ws + WS_QO); bf16* KB = (bf16*)(ws + WS_K); bf16* VB = (bf16*)(ws + WS_V);
    float* XA = (float*)(ws + WS_XA); bf16* ACT = (bf16*)(ws + WS_ACT); bf16* XS = (bf16*)(ws + WS_XS); bf16* ACT2 = (bf16*)(ws + WS_ACT2); bf16* YS = (bf16*)(ws + WS_YS);
    float* LOGFT = (float*)(ws + WS_LOGFT);

    if (IN(0)) { p0_prologue(F, args); } SEAM(0);
    if (IN(1)) { norm_mod_rows(F, args.in[0], args.in[4], MOD0 + 0 * D, MOD0 + 1 * D, XN); } SEAM(1);
    if (IN(2)) {
        fgate_groups(F, XN, (const bf16*)(ws + WS_WFT), args.in[8], LOGFT);
        pg8::Gemm g{XN, (const pg8::bf16_t*)(ws + WS_WFOXIN), M, 3 * D, D}; pg8::StaticOrder So; So.init(M, 3 * D, F.G, (int)blockIdx.x);
        pg8::EpiQKV<0> E{QO, (size_t)(WS_K - WS_QO) / 2, C2};
        pg8::gemm_phase<pg8::EpiQKV<0>, pg8::StaticOrder, true, true>(F.lds + RING_OFF, g, So, E, F.wave);
    } SEAM(2);
    if (IN(3)) {
        static_assert(attn_body::ATTN_LDS_BYTES <= 96 * 1024, "attention scratch vs the cumulative-gate table");
        const attn_body::AttnTensors AT{(const attn_body::bf16*)QO, (const attn_body::bf16*)KB, (const attn_body::bf16*)VB, (attn_body::bf16*)QO};
        attn_body::attn_phase((char*)lds + RING_OFF, AT, LOGFT, (LAS float*)(F.lds + RING_OFF + 96 * 1024), (LAS float*)(F.lds + RING_OFF + 112 * 1024), F.vcu, F.G, F.wave);
    } SEAM(3);
    if (IN(4)) {
        pg8::Gemm g{QO, (const pg8::bf16_t*)(ws + WS_WFOXOUT), M, D, D}; pg8::StaticOrder So; So.init(M, D, F.G, (int)blockIdx.x);
        pg8::EpiResid E{args.in[0], XA, MOD0 + 2 * D, D, S, NMOD};
        pg8::gemm_phase<pg8::EpiResid, pg8::StaticOrder, true, true>(F.lds + RING_OFF, g, So, E, F.wave);
    } SEAM(4);
    if (IN(5)) { norm_mod_rows(F, XA, args.in[5], MOD0 + 3 * D, MOD0 + 4 * D, XN); } SEAM(5);
    if (IN(6)) {
        pg8::Gemm g{XN, (const pg8::bf16_t*)(ws + WS_WGU), M, 2 * FF, D}; pg8::StaticOrder So; So.init(M, 2 * FF, F.G, (int)blockIdx.x);
        pg8::EpiSwiglu E{ACT, FF};
        pg8::gemm_phase<pg8::EpiSwiglu, pg8::StaticOrder, true, true>(F.lds + RING_OFF, g, So, E, F.wave);
    } SEAM(6);
    if (IN(7)) {
        pg8::Gemm g{ACT, (const pg8::bf16_t*)(ws + WS_WDN), M, D, FF}; pg8::StaticOrder So; So.init(M, D, F.G, (int)blockIdx.x);
        pg8::EpiResid E{XA, XA, MOD0 + 5 * D, D, S, NMOD};
        pg8::gemm_phase<pg8::EpiResid, pg8::StaticOrder, true, true>(F.lds + RING_OFF, g, So, E, F.wave);
    } SEAM(7);
    if (IN(8)) { norm_mod_rows(F, XA, args.in[4] + D, MOD1 + 0 * D, MOD1 + 1 * D, XN); } SEAM(8);
    if (IN(9)) {
        pg8::Gemm g{XN, (const pg8::bf16_t*)(ws + WS_WSWAIN), M, D + 512, D}; pg8::StaticOrder So; So.init(M, D + 512, F.G, (int)blockIdx.x);
        pg8::EpiQKV<1> E{QO, (size_t)(WS_K - WS_QO) / 2, C2};
        pg8::gemm_phase<pg8::EpiQKV<1>, pg8::StaticOrder, true, true>(F.lds + RING_OFF, g, So, E, F.wave);
    } SEAM(9);
    if (IN(10)) { swa_phase((char*)lds + RING_OFF, QO, KB, VB, QO, args.in[11], args.in[13], (LAS float*)(F.lds + RING_OFF + 96 * 1024), F.vcu, F.G, F.wave); } SEAM(10);
    if (IN(11)) {
        pg8::Gemm g{QO, (const pg8::bf16_t*)(ws + WS_WSWAOUT), M, D, D}; pg8::StaticOrder So; So.init(M, D, F.G, (int)blockIdx.x);
        pg8::EpiResid E{XA, XA, MOD1 + 2 * D, D, S, NMOD};
        pg8::gemm_phase<pg8::EpiResid, pg8::StaticOrder, true, true>(F.lds + RING_OFF, g, So, E, F.wave);
    } SEAM(11);
    if (IN(12)) { route_rows(F, XA, args.in[5] + D, MOD1 + 3 * D, MOD1 + 4 * D, args.in[16], args.in[17], XS, (int*)(ws + WS_LIST), (float*)(ws + WS_WL), F.ctl + CW_CNT); } SEAM(12);
    if (IN(13) || IN(14)) {
        volatile LAS int* tab = (volatile LAS int*)(F.lds + TAB_OFF);
        if (F.wave == 0 && pg8::pg8_lane_id() == 0) { int accp = 0;
            for (int e = 0; e < NE; ++e) { const int n = (int)__hip_atomic_load(F.ctl + CW_CNT + 64 * e, RLX_AGENT); tab[e] = accp; accp += (n + 255) >> 8; }
            tab[8] = accp; }
        __syncthreads();
    }
    if (IN(13)) {
        pg8::Gemm g{XS, (const pg8::bf16_t*)(ws + WS_WMGU), M, 2 * FF, D}; pg8::MoeOrder So; So.init((const LAS int*)(F.lds + TAB_OFF), 2 * FF / 256, F.G, (int)blockIdx.x, ECAP / 256);
        pg8::EpiSwiglu E{ACT2, FF};
        pg8::gemm_phase<pg8::EpiSwiglu, pg8::MoeOrder, true, true>(F.lds + RING_OFF, g, So, E, F.wave);
    } SEAM(13);
    if (IN(14)) {
        pg8::Gemm g{ACT2, (const pg8::bf16_t*)(ws + WS_WMDN), M, D, FF}; pg8::MoeOrder So; So.init((const LAS int*)(F.lds + TAB_OFF), D / 256, F.G, (int)blockIdx.x, 0);
        pg8::EpiScatter E{YS, (const int*)(ws + WS_LIST), (const float*)(ws + WS_WL), (const unsigned*)(F.ctl + CW_CNT), ECAP, 64};
        pg8::gemm_phase<pg8::EpiScatter, pg8::MoeOrder, true, true>(F.lds + RING_OFF, g, So, E, F.wave);
    } SEAM(14);
    if (IN(15)) { final_rows(F, XA, YS, MOD1 + 5 * D, args.in[6], args.out); }
#undef IN
#undef SEAM
}

extern "C" void kernel_launch(void* const* d_in, const int* in_sizes, int n_in, void* d_out, int out_size, void* d_ws, size_t ws_size, hipStream_t stream) {
    static int grid = 0;
    if (grid == 0) {
        if (n_in != 20 || out_size != M * D || ws_size < WS_END) { fprintf(stderr, "kernel_launch: unexpected problem (n_in %d, out %d, ws %zu)\n", n_in, out_size, ws_size); grid = -1; return; }
        int dev = 0, cus = 0, per_cu = 0;
        if (hipGetDevice(&dev) != hipSuccess || hipDeviceGetAttribute(&cus, hipDeviceAttributeMultiprocessorCount, dev) != hipSuccess) { grid = -1; return; }
        if (hipFuncSetAttribute((const void*)mk_fwd, hipFuncAttributeMaxDynamicSharedMemorySize, LDS_BYTES) != hipSuccess) { fprintf(stderr, "kernel_launch: hipFuncSetAttribute failed\n"); grid = -1; return; }
        if (hipOccupancyMaxActiveBlocksPerMultiprocessor(&per_cu, (const void*)mk_fwd, NWAVES * 64, LDS_BYTES) != hipSuccess || per_cu < 1) { fprintf(stderr, "kernel_launch: occupancy query reports %d\n", per_cu); (void)hipGetLastError(); grid = -1; return; }
        grid = cus;
    }
    if (grid < 0) return;
    if (hipMemsetAsync((char*)d_ws + WS_CTL, 0, CTL_ZERO_BYTES, stream) != hipSuccess) return;
    Args a{};
    for (int i = 0; i < 20; ++i) a.in[i] = (const float*)d_in[i];
    a.out = (float*)d_out; a.ws = (unsigned char*)d_ws; a.ph_lo = 0; a.ph_hi = 16;
    hipLaunchKernelGGL(mk_fwd, dim3(grid), dim3(NWAVES * 64), LDS_BYTES, stream, a);
}
```

```cpp
#include <hip/hip_runtime.h>
#include <cstdio>
#include <cstdint>
#include <cmath>
namespace pg8 {
#define PG8_LAS __attribute__((address_space(3)))
typedef unsigned short bf16_t;
typedef short bf16x8 __attribute__((ext_vector_type(8)));
typedef float f32x4 __attribute__((ext_vector_type(4)));
typedef unsigned u32x4 __attribute__((ext_vector_type(4)));
constexpr int BM = 256, BK = 64, HALF = 128, HTB = HALF * BK * 2  , STAGE_BYTES = 8 * HTB, NXCD = 8, WGM = 8;

__host__ __device__ __forceinline__ int lds_byte(int r, int c) { const int st = (r >> 4) * 2 + (c >> 5), rr = r & 15, cc = c & 31, ob = rr * 64 + cc * 2; return st * 1024 + (ob ^ (((ob >> 9) & 1) << 5)); }
__host__ __device__ __forceinline__ void stage_rc(int b, int& R, int& C) { const int st = b / 1024, sb = b % 1024, swz = sb ^ (((sb >> 9) & 1) << 5); R = (st >> 1) * 16 + swz / 64; C = (st & 1) * 32 + (swz % 64) / 2; }
__host__ __device__ __forceinline__ int perm32(int rho) { const int n = rho >> 4, i = rho & 15; return 8 * (i >> 2) + 4 * n + (i & 3); }
__device__ __forceinline__ int pg8_lane_id() { int l; asm volatile("v_mbcnt_lo_u32_b32 %0, -1, 0\n\tv_mbcnt_hi_u32_b32 %0, -1, %0" : "=v"(l)); return l; }
typedef int i32x4 __attribute__((ext_vector_type(4))); typedef int i32x8 __attribute__((ext_vector_type(8)));
__device__ __forceinline__ i32x8 pg8_cat(bf16x8 a, bf16x8 b) { return __builtin_shufflevector(__builtin_bit_cast(i32x4, a), __builtin_bit_cast(i32x4, b), 0, 1, 2, 3, 4, 5, 6, 7); }
__device__ __forceinline__ unsigned cvt_pk4_fp8(float a, float b, float c, float d) { int w = 0; w = __builtin_amdgcn_cvt_pk_fp8_f32(a, b, w, false); w = __builtin_amdgcn_cvt_pk_fp8_f32(c, d, w, true); return (unsigned)w; }
struct Unit { int pm, pn, orow, ocol, aux, mt; };
struct Gemm { const bf16_t* A; const bf16_t* Bt; int M, N, K; };

struct StaticOrder {
    int nM, nN, nwg, G, c;
    __device__ __forceinline__ void init(int M, int N, int G_, int c_) { nM = M / BM; nN = N / BM; nwg = nM * nN; G = G_; c = c_; }
    __device__ __forceinline__ bool next(int i, Unit& u) const {
        const long L = (long)i * G + c; if (L >= nwg) return false;
        int wgid = (int)L; { const int q = nwg / NXCD, r = nwg % NXCD, xcd = wgid % NXCD, off = wgid / NXCD; wgid = (xcd < r ? xcd * (q + 1) : r * (q + 1) + (xcd - r) * q) + off; }
        const int nig = WGM * nN, gid = wgid / nig, fm = gid * WGM, gsz = (nM - fm) < WGM ? (nM - fm) : WGM;
        u.pm = fm + ((wgid % nig) % gsz); u.pn = (wgid % nig) / gsz; u.orow = u.pm * BM; u.ocol = u.pn; u.aux = 0; u.mt = u.pm; return true;
    }
    __device__ __forceinline__ void a_ready(const Unit&) const {}
    __device__ __forceinline__ void done(const Unit&) const {}
};
struct MoeOrder {
    const PG8_LAS int* tab; int nN, G, c, TM, apt;
    __device__ __forceinline__ void init(const PG8_LAS int* tab_, int nN_, int G_, int c_, int apt_) { tab = tab_; nN = nN_; G = G_; c = c_; apt = apt_; TM = __builtin_amdgcn_readfirstlane(tab_[8]); }
    __device__ __forceinline__ bool next(int i, Unit& u) const {
        const int nwg = TM * nN; const long L = (long)i * G + c; if (L >= nwg) return false;
        int wgid = (int)L; { const int q = nwg / NXCD, r = nwg % NXCD, xcd = wgid % NXCD, off = wgid / NXCD; wgid = (xcd < r ? xcd * (q + 1) : r * (q + 1) + (xcd - r) * q) + off; }
        const int nig = WGM * nN, gid = wgid / nig, fm = gid * WGM, gsz = (TM - fm) < WGM ? (TM - fm) : WGM;
        const int gm = fm + ((wgid % nig) % gsz), pnl = (wgid % nig) / gsz;
        int e = 0;
#pragma unroll
        for (int j = 1; j < 8; ++j) e += (gm >= tab[j]) ? 1 : 0;
        e = __builtin_amdgcn_readfirstlane(e);
        const int t0 = __builtin_amdgcn_readfirstlane(tab[e]), mt = gm - t0;
        u.pm = apt ? e * apt + mt : t0 + mt; u.pn = e * nN + pnl; u.orow = (t0 + mt) * BM; u.ocol = pnl; u.aux = e; u.mt = mt; return true;
    }
    __device__ __forceinline__ void a_ready(const Unit&) const {}
    __device__ __forceinline__ void done(const Unit&) const {}
};

__device__ __forceinline__ unsigned cvt_pk_bf16(float lo, float hi) { unsigned r; asm volatile("v_cvt_pk_bf16_f32 %0, %1, %2" : "=v"(r) : "v"(lo), "v"(hi)); return r; }
__device__ __forceinline__ float silu_f(float v) { return v * __builtin_amdgcn_rcpf(1.0f + __builtin_amdgcn_exp2f(-1.4426950408889634f * v)); }

template <int MODE> struct EpiQKV {
    static constexpr bool PERM = true, AFTER_DRAIN = false;
    bf16_t* Q; size_t stride; float scale0;
    __device__ __forceinline__ void operator()(const f32x4 (&acc)[2][2][4][2], const Unit& u, int wr, int wc, int fr, int fq) const {
        const int pn = u.ocol; int t, ldc, colt;
        if (MODE == 0) { t = pn >> 2; ldc = 1024; colt = (pn & 3) * 256; }
        else { if (pn < 4) { t = 0; ldc = 1024; colt = pn * 256; } else { t = pn - 3; ldc = 256; colt = 0; } }
        bf16_t* base = Q + (size_t)t * stride; const float sc = (t == 0) ? scale0 : 1.f;
        const int row0 = u.orow + wr * 64 + fr, col0 = colt + wc * 32 + 8 * fq;
#pragma unroll
        for (int ai = 0; ai < 2; ++ai)
#pragma unroll
            for (int m = 0; m < 4; ++m) { bf16_t* rowp = base + (size_t)(row0 + ai * HALF + m * 16) * ldc + col0;
#pragma unroll
                for (int bj = 0; bj < 2; ++bj) { const f32x4 v0 = acc[ai][bj][m][0] * sc, v1 = acc[ai][bj][m][1] * sc;
                    u32x4 w; w.x = cvt_pk_bf16(v0[0], v0[1]); w.y = cvt_pk_bf16(v0[2], v0[3]); w.z = cvt_pk_bf16(v1[0], v1[1]); w.w = cvt_pk_bf16(v1[2], v1[3]);
                    *(u32x4*)(rowp + bj * HALF) = w; } }
    }
};
struct EpiResid {
    static constexpr bool PERM = false, AFTER_DRAIN = false;
    const float* xin; float* out; const float* gate; int ldc, rows_per_batch, gld;
    __device__ __forceinline__ void operator()(const f32x4 (&acc)[2][2][4][2], const Unit& u, int wr, int wc, int fr, int fq) const {
        const int row0 = u.orow + wr * 64 + fr, col0 = u.ocol * BM + wc * 32 + 4 * fq;
        const float* gp = gate + (size_t)(u.orow / rows_per_batch) * gld + col0;
        f32x4 gv[2][2];
#pragma unroll
        for (int bj = 0; bj < 2; ++bj)
#pragma unroll
            for (int n = 0; n < 2; ++n) gv[bj][n] = *(const f32x4*)(gp + bj * HALF + n * 16);
#pragma unroll
        for (int ai = 0; ai < 2; ++ai)
#pragma unroll
            for (int m = 0; m < 4; ++m) { const size_t off = (size_t)(row0 + ai * HALF + m * 16) * ldc + col0;
#pragma unroll
                for (int bj = 0; bj < 2; ++bj)
#pragma unroll
                    for (int n = 0; n < 2; ++n) { const f32x4 xv = *(const f32x4*)(xin + off + bj * HALF + n * 16); *(f32x4*)(out + off + bj * HALF + n * 16) = xv + gv[bj][n] * acc[ai][bj][m][n]; }
                asm volatile("" ::: "memory"); }
    }
};
template <bool FP8OUT> struct EpiSwiglu {
    static constexpr bool PERM = true, AFTER_DRAIN = false;
    void* O; int ldc; float sc, oscale;
    __device__ __forceinline__ void operator()(const f32x4 (&acc)[2][2][4][2], const Unit& u, int wr, int wc, int fr, int fq) const {
        const int row0 = u.orow + wr * 64 + fr, col0 = u.ocol * HALF + wc * 32 + 8 * fq;
#pragma unroll
        for (int ai = 0; ai < 2; ++ai)
#pragma unroll
            for (int m = 0; m < 4; ++m) { const size_t off = (size_t)(row0 + ai * HALF + m * 16) * ldc + col0;
                const f32x4 g0 = acc[ai][0][m][0] * sc, g1 = acc[ai][0][m][1] * sc, u0 = acc[ai][1][m][0] * (sc * oscale), u1 = acc[ai][1][m][1] * (sc * oscale);
                float v[8];
#pragma unroll
                for (int i = 0; i < 4; ++i) { v[i] = silu_f(g0[i]) * u0[i]; v[4 + i] = silu_f(g1[i]) * u1[i]; }
                if constexpr (FP8OUT) { typedef unsigned u32x2 __attribute__((ext_vector_type(2))); u32x2 w; w.x = cvt_pk4_fp8(v[0], v[1], v[2], v[3]); w.y = cvt_pk4_fp8(v[4], v[5], v[6], v[7]); *(u32x2*)((unsigned char*)O + off) = w; }
                else { u32x4 w; w.x = cvt_pk_bf16(v[0], v[1]); w.y = cvt_pk_bf16(v[2], v[3]); w.z = cvt_pk_bf16(v[4], v[5]); w.w = cvt_pk_bf16(v[6], v[7]); *(u32x4*)((bf16_t*)O + off) = w; } }
    }
};
struct EpiScatter {
    static constexpr bool PERM = true, AFTER_DRAIN = false;
    bf16_t* YS; const int* list; const float* wl; const unsigned* cnt; int lpitch, cstride; float sc;
    __device__ __forceinline__ void operator()(const f32x4 (&acc)[2][2][4][2], const Unit& u, int wr, int wc, int fr, int fq) const {
        const int e = u.aux, ne = (int)cnt[e * cstride], p0 = u.mt * BM + wr * 64 + fr, col0 = u.ocol * BM + wc * 32 + 8 * fq;
#pragma unroll
        for (int ai = 0; ai < 2; ++ai)
#pragma unroll
            for (int m = 0; m < 4; ++m) { const int p = p0 + ai * HALF + m * 16;
                if (p < ne) { const int t2 = list[e * lpitch + p]; const float w = wl[e * lpitch + p] * sc; bf16_t* rowp = YS + (size_t)t2 * 1024 + col0;
#pragma unroll
                    for (int bj = 0; bj < 2; ++bj) { const f32x4 v0 = acc[ai][bj][m][0] * w, v1 = acc[ai][bj][m][1] * w;
                        u32x4 q; q.x = cvt_pk_bf16(v0[0], v0[1]); q.y = cvt_pk_bf16(v0[2], v0[3]); q.z = cvt_pk_bf16(v1[0], v1[1]); q.w = cvt_pk_bf16(v1[2], v1[3]);
                        *(u32x4*)(rowp + bj * HALF) = q; } } }
    }
};

template <class Epi, class Sched, bool ALIGN_EPI = false, bool SP2 = false, bool FP8 = false>
__device__ __forceinline__ void gemm_phase(PG8_LAS unsigned char* lds, const Gemm g, const Sched& S, const Epi& E, const int wid) {
    const int lane = pg8_lane_id(), tid = wid * 64 + lane, wr = wid >> 2, wc = wid & 3, fr = lane & 15, fq = lane >> 4;
    const int K = g.K, nt = K / BK;
    unsigned voffA[2], voffB[2];
#pragma unroll
    for (int i = 0; i < 2; ++i) { int R, C; stage_rc(tid * 16 + i * 8192, R, C); const int Rb = Epi::PERM ? ((R & ~31) + perm32(R & 31)) : R;
        voffA[i] = (unsigned)(R * K + C) * 2u; voffB[i] = (unsigned)(Rb * K + C) * 2u; }
    const size_t kstep = (size_t)(BK * 2);
    const size_t hstep = (size_t)HALF * K * 2;
    const size_t tstep = 2 * hstep;
    const unsigned ldsw = (unsigned)wid * 1024u;
    const int aoff = lds_byte(wr * 64 + fr, fq * 8), boff = lds_byte(wc * 32 + fr, fq * 8);
#define PG8_SA(b, h) (((b) * 2 + (h)) * HTB)
#define PG8_SB(b, h) ((4 + (b) * 2 + (h)) * HTB)
#define PG8_STAGE(bufoff, gbase, voff) do { _Pragma("unroll") for (int _i = 0; _i < 2; ++_i) \
        __builtin_amdgcn_global_load_lds((const unsigned*)((const char*)(gbase) + (voff)[_i]), (PG8_LAS unsigned*)(lds + (bufoff) + ldsw + _i * 8192), 16, 0, 0); } while (0)
#define PG8_LDA(dst, b, h) do { if constexpr (FP8) { _Pragma("unroll") for (int m = 0; m < 4; ++m) dst##8[m] = pg8_cat(*(const PG8_LAS bf16x8*)(lds + PG8_SA(b, h) + aoff + m * 2048), *(const PG8_LAS bf16x8*)(lds + PG8_SA(b, h) + aoff + m * 2048 + 1024)); } else { \
        _Pragma("unroll") for (int m = 0; m < 4; ++m) _Pragma("unroll") for (int k = 0; k < 2; ++k) dst[m][k] = *(const PG8_LAS bf16x8*)(lds + PG8_SA(b, h) + aoff + m * 2048 + k * 1024); } } while (0)
#define PG8_LDB(dst, b, h) do { if constexpr (FP8) { _Pragma("unroll") for (int n = 0; n < 2; ++n) dst##8[n] = pg8_cat(*(const PG8_LAS bf16x8*)(lds + PG8_SB(b, h) + boff + n * 2048), *(const PG8_LAS bf16x8*)(lds + PG8_SB(b, h) + boff + n * 2048 + 1024)); } else { \
        _Pragma("unroll") for (int n = 0; n < 2; ++n) _Pragma("unroll") for (int k = 0; k < 2; ++k) dst[n][k] = *(const PG8_LAS bf16x8*)(lds + PG8_SB(b, h) + boff + n * 2048 + k * 1024); } } while (0)
#define PG8_MMA(ai, bj, At, Bt) do { __builtin_amdgcn_s_setprio(1); if constexpr (FP8) { _Pragma("unroll") for (int m = 0; m < 4; ++m) _Pragma("unroll") for (int n = 0; n < 2; ++n) \
        asm volatile("v_mfma_f32_16x16x128_f8f6f4 %0, %1, %2, %0" : "+v"(acc[ai][bj][m][n]) : "v"(Bt##8[n]), "v"(At##8[m])); } else { \
        _Pragma("unroll") for (int m = 0; m < 4; ++m) _Pragma("unroll") for (int n = 0; n < 2; ++n) _Pragma("unroll") for (int k = 0; k < 2; ++k) \
        acc[ai][bj][m][n] = __builtin_amdgcn_mfma_f32_16x16x32_bf16(Bt[n][k], At[m][k], acc[ai][bj][m][n], 0, 0, 0); } __builtin_amdgcn_s_setprio(0); } while (0)
#define PG8_WAIT_V(n) asm volatile("s_waitcnt vmcnt(" #n ")" ::: "memory")
#define PG8_WAIT_L(n) asm volatile("s_waitcnt lgkmcnt(" #n ")" ::: "memory")
#define PG8_BAR __builtin_amdgcn_s_barrier()
#define PG8_SCHED __builtin_amdgcn_sched_barrier(0)
    Unit cur, nxt; int ui = 0;
    if (!S.next(0, cur)) return;
    f32x4 acc[2][2][4][2];
#pragma unroll
    for (int a = 0; a < 2; ++a)
#pragma unroll
        for (int b = 0; b < 2; ++b)
#pragma unroll
            for (int m = 0; m < 4; ++m)
#pragma unroll
                for (int n = 0; n < 2; ++n) acc[a][b][m][n] = (f32x4){0.f, 0.f, 0.f, 0.f};
    bf16x8 At[4][2], B0[2][2], B1[2][2]; i32x8 At8[4], B08[2], B18[2];
    const char* cA = (const char*)g.A + (size_t)cur.pm * tstep; const char* cB = (const char*)g.Bt + (size_t)cur.pn * tstep;
    S.a_ready(cur);
    if constexpr (SP2) {
        PG8_STAGE(PG8_SB(0, 0), cB, voffB); PG8_STAGE(PG8_SB(0, 1), cB + hstep, voffB); PG8_STAGE(PG8_SA(0, 0), cA, voffA); PG8_STAGE(PG8_SA(0, 1), cA + hstep, voffA);
        if (wr == 1) PG8_BAR;
        PG8_WAIT_V(2); PG8_BAR;
        PG8_STAGE(PG8_SB(1, 0), cB + kstep, voffB); PG8_STAGE(PG8_SA(1, 0), cA + kstep, voffA); PG8_STAGE(PG8_SB(1, 1), cB + hstep + kstep, voffB);
        PG8_WAIT_V(6); PG8_BAR;
    } else {
        PG8_STAGE(PG8_SB(0, 0), cB, voffB); PG8_STAGE(PG8_SA(0, 0), cA, voffA); PG8_STAGE(PG8_SB(0, 1), cB + hstep, voffB); PG8_STAGE(PG8_SA(0, 1), cA + hstep, voffA);
        if (wr == 1) PG8_BAR;
        PG8_WAIT_V(4); PG8_BAR;
        PG8_STAGE(PG8_SB(1, 0), cB + kstep, voffB); PG8_STAGE(PG8_SA(1, 0), cA + kstep, voffA); PG8_STAGE(PG8_SB(1, 1), cB + hstep + kstep, voffB);
        PG8_WAIT_V(6); PG8_BAR;
    }
    for (;;) {
        const bool has_next = S.next(ui + 1, nxt);
        const char* nA = has_next ? (const char*)g.A + (size_t)nxt.pm * tstep : cA; const char* nB = has_next ? (const char*)g.Bt + (size_t)nxt.pn * tstep : cB;
#pragma unroll 1
        for (int t = 0; t < nt; t += 2) {
            const bool last = (t == nt - 2);
            const char* a1 = cA + (size_t)(t + 1) * kstep;
            const char* a2 = last ? nA : cA + (size_t)(t + 2) * kstep; const char* b2 = last ? nB : cB + (size_t)(t + 2) * kstep;
            const char* a3 = a2 + kstep; const char* b3 = b2 + kstep;
            if (last && has_next) S.a_ready(nxt);
            if constexpr (SP2) {
            PG8_LDB(B0, 0, 0); PG8_LDB(B1, 0, 1); PG8_SCHED; PG8_LDA(At, 0, 0); PG8_STAGE(PG8_SA(1, 1), a1 + hstep, voffA);
            PG8_WAIT_V(8); PG8_WAIT_L(0); PG8_BAR; PG8_MMA(0, 0, At, B0); PG8_MMA(0, 1, At, B1); PG8_BAR; PG8_SCHED;
            PG8_LDA(At, 0, 1); PG8_STAGE(PG8_SB(0, 0), b2, voffB); PG8_STAGE(PG8_SB(0, 1), b2 + hstep, voffB); PG8_STAGE(PG8_SA(0, 0), a2, voffA);
            PG8_WAIT_V(8); PG8_WAIT_L(0); PG8_BAR; PG8_MMA(1, 0, At, B0); PG8_MMA(1, 1, At, B1); PG8_BAR; PG8_SCHED;
            PG8_LDB(B0, 1, 0); PG8_LDB(B1, 1, 1); PG8_SCHED; PG8_LDA(At, 1, 0); PG8_STAGE(PG8_SA(0, 1), a2 + hstep, voffA);
            PG8_WAIT_V(8); PG8_WAIT_L(0); PG8_BAR; PG8_MMA(0, 0, At, B0); PG8_MMA(0, 1, At, B1); PG8_BAR; PG8_SCHED;
            PG8_LDA(At, 1, 1); PG8_STAGE(PG8_SB(1, 0), b3, voffB); PG8_STAGE(PG8_SB(1, 1), b3 + hstep, voffB); PG8_STAGE(PG8_SA(1, 0), a3, voffA);
            PG8_WAIT_V(8); PG8_WAIT_L(0); PG8_BAR; PG8_MMA(1, 0, At, B0); PG8_MMA(1, 1, At, B1); PG8_BAR; PG8_SCHED;
            } else {
            PG8_LDB(B0, 0, 0); PG8_SCHED; PG8_LDA(At, 0, 0); PG8_STAGE(PG8_SA(1, 1), a1 + hstep, voffA);
            PG8_WAIT_L(8); PG8_BAR; PG8_WAIT_L(0); PG8_MMA(0, 0, At, B0); PG8_BAR; PG8_SCHED;
            PG8_LDB(B1, 0, 1); PG8_STAGE(PG8_SB(0, 0), b2, voffB);
            PG8_BAR; PG8_WAIT_L(0); PG8_MMA(0, 1, At, B1); PG8_BAR;
            PG8_LDA(At, 0, 1); PG8_STAGE(PG8_SA(0, 0), a2, voffA);
            PG8_BAR; PG8_WAIT_L(0); PG8_MMA(1, 0, At, B0); PG8_BAR; PG8_SCHED;
            PG8_STAGE(PG8_SB(0, 1), b2 + hstep, voffB);
            PG8_WAIT_V(6); PG8_BAR; PG8_MMA(1, 1, At, B1); PG8_BAR;
            PG8_LDB(B0, 1, 0); PG8_SCHED; PG8_LDA(At, 1, 0); PG8_STAGE(PG8_SA(0, 1), a2 + hstep, voffA);
            PG8_WAIT_L(8); PG8_BAR; PG8_WAIT_L(0); PG8_MMA(0, 0, At, B0); PG8_BAR; PG8_SCHED;
            PG8_LDB(B1, 1, 1); PG8_STAGE(PG8_SB(1, 0), b3, voffB);
            PG8_BAR; PG8_WAIT_L(0); PG8_MMA(0, 1, At, B1); PG8_BAR;
            PG8_LDA(At, 1, 1); PG8_STAGE(PG8_SA(1, 0), a3, voffA);
            PG8_BAR; PG8_WAIT_L(0); PG8_MMA(1, 0, At, B0); PG8_BAR; PG8_SCHED;
            PG8_STAGE(PG8_SB(1, 1), b3 + hstep, voffB);
            PG8_WAIT_V(6); PG8_BAR; PG8_MMA(1, 1, At, B1); PG8_BAR;
            }
        }
        if constexpr (ALIGN_EPI) { if (wr == 0) PG8_BAR; }
        if constexpr (FP8) asm volatile("s_nop 15\n\ts_nop 15" ::: "memory");
        if constexpr (!Epi::AFTER_DRAIN) { E(acc, cur, wr, wc, fr, fq); S.done(cur); }
        if (!has_next) break;
#pragma unroll
        for (int a = 0; a < 2; ++a)
#pragma unroll
            for (int b = 0; b < 2; ++b)
#pragma unroll
                for (int m = 0; m < 4; ++m)
#pragma unroll
                    for (int n = 0; n < 2; ++n) acc[a][b][m][n] = (f32x4){0.f, 0.f, 0.f, 0.f};
        cur = nxt; cA = nA; cB = nB; ++ui;
        if constexpr (ALIGN_EPI) { if (wr == 1) PG8_BAR; }
    }
    PG8_WAIT_V(0);
    if constexpr (!ALIGN_EPI) { if (wr == 0) PG8_BAR; }
    PG8_BAR;
    if constexpr (Epi::AFTER_DRAIN) { E.fused(acc, cur, wr, wc, fr, fq, lds, wid, lane); S.done(cur); }
#undef PG8_SA
#undef PG8_SB
#undef PG8_STAGE
#undef PG8_LDA
#undef PG8_LDB
#undef PG8_MMA
#undef PG8_WAIT_V
#undef PG8_WAIT_L
#undef PG8_BAR
#undef PG8_SCHED
}
}

#include <hip/hip_bf16.h>
namespace attn_body {
using bf16=__hip_bfloat16;
using bf16x8=__attribute__((ext_vector_type(8)))short;
using s16x4=__attribute__((ext_vector_type(4)))short;
using f32x16=__attribute__((ext_vector_type(16)))float;
using u32x4=__attribute__((ext_vector_type(4)))unsigned;
constexpr int BATCH=4,NHEAD=16,SEQ=4096,D=64,DM=NHEAD*D;
constexpr int NW=8,QBLK=32,QB=QBLK*NW,KVBLK=64,NQB=SEQ/QB;
constexpr int ATTN_PITCH=DM, ATTN_UNIT_ROWS=QB;
__device__ __forceinline__ int crow(int r,int hi){return (r&3)+8*(r>>2)+4*hi;}
#define SBAR() __builtin_amdgcn_sched_barrier(0)
__device__ __forceinline__ void cmask(f32x16&p0,f32x16&p1,int jb,int qrel,int hi){
  const float NEG=-INFINITY; int kb=64*jb+4*hi;
  #pragma unroll
  for(int r=0;r<16;++r){int kv=kb+(r&3)+8*(r>>2); if(kv>qrel)p0[r]=NEG; if(kv+32>qrel)p1[r]=NEG;}
}

constexpr int NSLOT=3, SLOTB=8192;
constexpr int LDS_K=0, LDS_V=NSLOT*SLOTB, LDS_WS=2*NSLOT*SLOTB, LDS_OST=LDS_WS+NW*64*4, LDS_BYTES=LDS_OST+NW*4096;
constexpr float C2=0.125f*1.4426950408889634f;
__device__ __forceinline__ void glds16(const void*gsrc,unsigned lds_dst){unsigned keep;
  asm volatile("s_mov_b32 %0, m0\n\ts_mov_b32 m0, %2\n\ts_nop 0\n\tglobal_load_lds_dwordx4 %1, off\n\ts_mov_b32 m0, %0":"=&s"(keep):"v"(gsrc),"s"(lds_dst):"memory");}
__device__ __forceinline__ float max3f(float a,float b,float c){float r;asm("v_max3_f32 %0, %1, %2, %3":"=v"(r):"v"(a),"v"(b),"v"(c));return r;}
__device__ __forceinline__ float max2f(float a,float b){float r;asm("v_max_f32_e32 %0, %1, %2":"=v"(r):"v"(a),"v"(b));return r;}
__device__ __forceinline__ float fadd_s(float a,float b){float r;asm("v_add_f32_e32 %0, %1, %2":"=v"(r):"v"(a),"v"(b));return r;}
__device__ __forceinline__ float fsub_s(float a,float b){float r;asm("v_sub_f32_e32 %0, %1, %2":"=v"(r):"v"(a),"v"(b));return r;}
typedef float f32x2_t __attribute__((ext_vector_type(2))); typedef __bf16 bf16x2_t __attribute__((ext_vector_type(2)));
__device__ __forceinline__ unsigned cvtpk_s(float lo,float hi){f32x2_t v={lo,hi};bf16x2_t b=__builtin_convertvector(v,bf16x2_t);return __builtin_bit_cast(unsigned,b);}
#define WAIT_BAR(N) asm volatile("s_waitcnt vmcnt(" #N ") lgkmcnt(0)\n\ts_barrier":::"memory")

__device__ __forceinline__ void qkt(f32x16&p0,f32x16&p1,const char*Kslot,const bf16x8*qr,int r32,int hi){
  const char*kb=Kslot+hi*1024+r32*16;
  #pragma unroll
  for(int d0=0;d0<4;++d0){
    const bf16x8 b0=*reinterpret_cast<const bf16x8*>(kb+d0*2048);
    const bf16x8 b1=*reinterpret_cast<const bf16x8*>(kb+d0*2048+512);
    p0=__builtin_amdgcn_mfma_f32_32x32x16_bf16(b0,qr[d0],p0,0,0,0);p1=__builtin_amdgcn_mfma_f32_32x32x16_bf16(b1,qr[d0],p1,0,0,0);}
}
typedef __attribute__((address_space(3))) const char* lds_cptr;
typedef short v4i16_t __attribute__((ext_vector_type(4)));
__device__ __forceinline__ void kload8(bf16x8*kf,lds_cptr kp){
  kf[0]=*(const __attribute__((address_space(3))) bf16x8*)(kp);      kf[1]=*(const __attribute__((address_space(3))) bf16x8*)(kp+512);
  kf[2]=*(const __attribute__((address_space(3))) bf16x8*)(kp+2048); kf[3]=*(const __attribute__((address_space(3))) bf16x8*)(kp+2560);
  kf[4]=*(const __attribute__((address_space(3))) bf16x8*)(kp+4096); kf[5]=*(const __attribute__((address_space(3))) bf16x8*)(kp+4608);
  kf[6]=*(const __attribute__((address_space(3))) bf16x8*)(kp+6144); kf[7]=*(const __attribute__((address_space(3))) bf16x8*)(kp+6656);
}
__device__ __forceinline__ void kload2(bf16x8*kf,lds_cptr kp,int j){ kf[2*j]=*(const __attribute__((address_space(3))) bf16x8*)(kp+j*2048); kf[2*j+1]=*(const __attribute__((address_space(3))) bf16x8*)(kp+j*2048+512); }
__device__ __forceinline__ s16x4 vtr(lds_cptr p){ return __builtin_bit_cast(s16x4,__builtin_amdgcn_ds_read_tr16_b64_v4i16((__attribute__((address_space(3))) v4i16_t*)p)); }
__device__ __forceinline__ float rowmax(const f32x16&p0,const f32x16&p1){
  float a=max3f(p0[0],p0[1],p1[0]),b=max3f(p0[2],p0[3],p1[1]);a=max3f(a,p1[2],p1[3]);
  #pragma unroll
  for(int r=4;r<16;r+=4){a=max3f(a,p0[r],p0[r+1]);b=max3f(b,p0[r+2],p0[r+3]);a=max3f(a,p1[r],p1[r+1]);b=max3f(b,p1[r+2],p1[r+3]);}
  const float m=max2f(a,b);
  auto rr=__builtin_amdgcn_permlane32_swap(__float_as_uint(m),__float_as_uint(m),false,false);
  return max2f(__uint_as_float(rr[0]),__uint_as_float(rr[1]));
}
__device__ __forceinline__ void pv(f32x16*o,int vb,bf16x8 pa0,bf16x8 pa1,bf16x8 pa2,bf16x8 pa3){
  #pragma unroll
  for(int d0=0;d0<2;++d0){s16x4 lo[4],hi[4];
    #pragma unroll
    for(int ks=0;ks<4;++ks){
      asm volatile("ds_read_b64_tr_b16 %0,%1 offset:%c2":"=&v"(lo[ks]):"v"(vb),"i"(d0*4096+ks*1024):"memory");
      asm volatile("ds_read_b64_tr_b16 %0,%1 offset:%c2":"=&v"(hi[ks]):"v"(vb),"i"(d0*4096+ks*1024+512):"memory");}
    asm volatile("s_waitcnt lgkmcnt(0)":::"memory");SBAR();
    #define PK(k) (bf16x8){lo[k][0],lo[k][1],lo[k][2],lo[k][3],hi[k][0],hi[k][1],hi[k][2],hi[k][3]}
    o[d0]=__builtin_amdgcn_mfma_f32_32x32x16_bf16(pa0,PK(0),o[d0],0,0,0);
    o[d0]=__builtin_amdgcn_mfma_f32_32x32x16_bf16(pa1,PK(1),o[d0],0,0,0);
    o[d0]=__builtin_amdgcn_mfma_f32_32x32x16_bf16(pa2,PK(2),o[d0],0,0,0);
    o[d0]=__builtin_amdgcn_mfma_f32_32x32x16_bf16(pa3,PK(3),o[d0],0,0,0);
    #undef PK
  }
}

#ifndef ATTN_STORE16
#define ATTN_STORE16(p,v) (*(u32x4*)(p)=(v))
#endif
typedef __attribute__((address_space(3))) const float* lds_cfptr; typedef float f32x4_t __attribute__((ext_vector_type(4)));
constexpr float MFLOOR=-100.f;
template<int THRL> __device__ __forceinline__ void attn_unit(int b,int h,int qb,const bf16*Q,const bf16*__restrict__ K,const bf16*__restrict__ V,bf16*O,char*shm,lds_cfptr cum,const int wid){
  const int lane=pg8::pg8_lane_id(),r32=lane&31,hi=lane>>5;
  const long rowbase=(long)b*SEQ; const int q0=qb*QB;
  const bf16*Qw=Q+(rowbase+q0+wid*QBLK)*DM+h*D;
  const bf16*Kh=K+rowbase*DM+h*D,*Vh=V+rowbase*DM+h*D;
  const unsigned lds0=(unsigned)(uintptr_t)shm;
  float*wsf=(float*)(shm+LDS_WS)+wid*64;
  const bf16*ksrc=Kh+(long)lane*DM+wid*8;
  const bf16*vsrc=Vh+(long)(16*(wid&3)+(lane>>2))*DM+(wid>>2)*32+(lane&3)*8;
  const unsigned kdst=lds0+LDS_K+wid*1024, vdst=lds0+LDS_V+wid*1024;
  #define DMA_K(t,slot) glds16(ksrc+(long)(NT-1-(t))*KVBLK*DM,(unsigned)__builtin_amdgcn_readfirstlane(kdst+(slot)))
  #define DMA_V(t,slot) glds16(vsrc+(long)(NT-1-(t))*KVBLK*DM,(unsigned)__builtin_amdgcn_readfirstlane(vdst+(slot)))
  const char*Kbase=shm+LDS_K; bf16x8 kf[8];
  const lds_cptr shm3=(lds_cptr)shm; const lds_cptr kp0=shm3+LDS_K+hi*1024+r32*16; const lds_cptr vp0=shm3+LDS_V+((lane>>4)&1)*32+(lane&3)*8+(4*hi+((lane&15)>>2))*64;
  const int NT=(q0+QB)/KVBLK;
  DMA_K(0,0);DMA_V(0,0);DMA_K(1,SLOTB);
  bf16x8 qr[4];
  #pragma unroll
  for(int d0=0;d0<4;++d0)qr[d0]=*reinterpret_cast<const bf16x8*>(&Qw[(long)r32*DM+d0*16+hi*8]);
  float l_reg=0.f;f32x16 o[2];o[0]=f32x16{};o[1]=f32x16{};
  float cbase=cum[q0+wid*QBLK+r32];
  #define CINITH(CX,t,OFS) do{ const lds_cfptr cb_=cum+(NT-1-(t))*KVBLK+4*hi+(OFS); const float bs_=cbase; \
    _Pragma("unroll") for(int g_=0;g_<4;++g_){ const f32x4_t a_=*(const __attribute__((address_space(3))) f32x4_t*)(cb_+8*g_); \
      CX[4*g_]=bs_-a_[0];CX[4*g_+1]=bs_-a_[1];CX[4*g_+2]=bs_-a_[2];CX[4*g_+3]=bs_-a_[3]; } }while(0)
  #define CINIT(C0,C1,t) do{ CINITH(C0,t,0); CINITH(C1,t,32); }while(0)
  const int qrel=wid*QBLK+r32;
  #define CMASK(P0,P1,t) do{int jb_=3-(t); if(jb_>=0)cmask(P0,P1,jb_,qrel,hi);}while(0)
  bool resc=false;
  #define START(P0,P1) do{ const float rm=rowmax(P0,P1); resc=false; \
    { const float dl=max2f(rm,MFLOOR); cbase=fsub_s(cbase,dl); \
      _Pragma("unroll") for(int r=0;r<16;++r){P0[r]=fsub_s(P0[r],dl);P1[r]=fsub_s(P1[r],dl);} } \
    _Pragma("unroll") for(int r=0;r<16;++r)P0[r]=__builtin_amdgcn_exp2f(P0[r]); }while(0)
  #define RESC() do{ if(resc){ asm volatile("s_waitcnt lgkmcnt(0)":::"memory"); const int hx_=pg8::pg8_lane_id()>>5; \
      _Pragma("unroll") for(int d_=0;d_<2;++d_) _Pragma("unroll") for(int r=0;r<16;++r)o[d_][r]*=wsf[crow(r,hx_)]; } }while(0)
  f32x16 pA0,pA1,pB0,pB1;
  int sl_prev=0,sl_cur=0,sl_next=SLOTB;
  #define ROT() do{sl_prev=sl_cur;sl_cur=sl_next;sl_next=(sl_next==(NSLOT-1)*SLOTB)?0:sl_next+SLOTB;}while(0)
  DMA_K(2,2*SLOTB);
  WAIT_BAR(3);
  CINIT(pA0,pA1,0); qkt(pA0,pA1,Kbase,qr,r32,hi);asm volatile("s_nop 15\n\ts_nop 7":"+v"(pA0),"+v"(pA1));CMASK(pA0,pA1,0);
  START(pA0,pA1);
  _Pragma("unroll") for(int r=0;r<16;++r)pA1[r]=__builtin_amdgcn_exp2f(pA1[r]);
  WAIT_BAR(0);
  DMA_K(3,0);DMA_V(1,SLOTB);
  ROT();
  kload8(kf,kp0+sl_cur);
  WAIT_BAR(2);
  s16x4 vlo[8],vhi[8]; u32x4 pw0,pw1,pw2,pw3;
  #define PKW(P,B) cvtpk_s(P[B],P[B+1])
  #define PAF(k) __builtin_bit_cast(bf16x8,pw##k)
  #define VFR(i) (bf16x8){vlo[i][0],vlo[i][1],vlo[i][2],vlo[i][3],vhi[i][0],vhi[i][1],vhi[i][2],vhi[i][3]}
  #define PIN(x) asm volatile("":"+v"(x))
  #define MX3(a,b,c) __builtin_fmaxf(__builtin_fmaxf((a),(b)),(c))
  #define GAPA(MF,A0,A1,A2,A3,W0,W1,PW) do{ MF; sacc+=A0; sacc+=A1; sacc+=A2; sacc+=A3; PIN(sacc); W0; W1; PIN(PW); SBAR(); }while(0)
  #define EX(v) __builtin_amdgcn_exp2f(v)
  #define GAPB(MF,X,B) do{ MF; X[B]=EX(X[B]); X[B+1]=EX(X[B+1]); X[B+2]=EX(X[B+2]); X[B+3]=EX(X[B+3]); PIN(X); SBAR(); }while(0)
  #define VRD(i) do{ vlo[i]=vtr(vp_+(((i)>>2)*4096+((i)&3)*1024)); vhi[i]=vtr(vp_+(((i)>>2)*4096+((i)&3)*1024+512)); }while(0)
  #define KRD(G,j) do{ if(G){ kload2(kf,kp0+sl_next,j); SBAR(); } }while(0)
  #define STEP(C0,C1,P0,P1,t,GK,GV,GL) do{ CINITH(C0,t,0); SBAR(); \
    const lds_cptr vp_=vp0+sl_prev; \
    VRD(0); SBAR(); float sacc=(P0[0]+P0[1]); \
    GAPA(C0=__builtin_amdgcn_mfma_f32_32x32x16_bf16(kf[0],qr[0],C0,0,0,0), P0[2],P0[3],P0[4],P0[5],     pw0[0]=PKW(P0,0), pw0[1]=PKW(P0,2), pw0); \
    CINITH(C1,t,32); SBAR(); VRD(4); SBAR(); GAPA(C1=__builtin_amdgcn_mfma_f32_32x32x16_bf16(kf[1],qr[0],C1,0,0,0), P0[6],P0[7],P0[8],P0[9],     pw0[2]=PKW(P0,4), pw0[3]=PKW(P0,6), pw0); \
    VRD(1); SBAR(); GAPA(C0=__builtin_amdgcn_mfma_f32_32x32x16_bf16(kf[2],qr[1],C0,0,0,0),   P0[10],P0[11],P0[12],P0[13], pw1[0]=PKW(P0,8), pw1[1]=PKW(P0,10), pw1); \
    VRD(5); SBAR(); GAPA(C1=__builtin_amdgcn_mfma_f32_32x32x16_bf16(kf[3],qr[1],C1,0,0,0),   P0[14],P0[15],P1[0],P1[1],   pw1[2]=PKW(P0,12),pw1[3]=PKW(P0,14), pw1); \
    VRD(2); SBAR(); GAPA(C0=__builtin_amdgcn_mfma_f32_32x32x16_bf16(kf[4],qr[2],C0,0,0,0),   P1[2],P1[3],P1[4],P1[5],     pw2[0]=PKW(P1,0), pw2[1]=PKW(P1,2), pw2); \
    VRD(6); SBAR(); GAPA(C1=__builtin_amdgcn_mfma_f32_32x32x16_bf16(kf[5],qr[2],C1,0,0,0),   P1[6],P1[7],P1[8],P1[9],     pw2[2]=PKW(P1,4), pw2[3]=PKW(P1,6), pw2); \
    VRD(3); SBAR(); GAPA(C0=__builtin_amdgcn_mfma_f32_32x32x16_bf16(kf[6],qr[3],C0,0,0,0),   P1[10],P1[11],P1[12],P1[13], pw3[0]=PKW(P1,8), pw3[1]=PKW(P1,10), pw3); \
    VRD(7); SBAR(); GAPA(C1=__builtin_amdgcn_mfma_f32_32x32x16_bf16(kf[7],qr[3],C1,0,0,0),   P1[14],P1[15],0.f,0.f,       pw3[2]=PKW(P1,12),pw3[3]=PKW(P1,14), pw3); \
    l_reg+=sacc; \
    if(GK){DMA_K((t)+3,sl_cur);} if(GV){DMA_V((t)+1,sl_next);} \
    CMASK(C0,C1,t); \
    { float a=MX3(C0[0],C0[1],C1[0]),b=MX3(C0[2],C0[3],C1[1]); a=MX3(a,C1[2],C1[3]); \
      _Pragma("unroll") for(int r=4;r<16;r+=4){a=MX3(a,C0[r],C0[r+1]);b=MX3(b,C0[r+2],C0[r+3]);a=MX3(a,C1[r],C1[r+1]);b=MX3(b,C1[r+2],C1[r+3]);} \
      float rm=__builtin_fmaxf(a,b); { auto rr=__builtin_amdgcn_permlane32_swap(__float_as_uint(rm),__float_as_uint(rm),false,false); rm=__builtin_fmaxf(__uint_as_float(rr[0]),__uint_as_float(rr[1])); } \
      resc=false; \
      if(__builtin_expect(__any(rm>(float)THRL),0)){ const float dl=__builtin_fmaxf(rm,0.f); cbase-=dl; \
        _Pragma("unroll") for(int r=0;r<16;++r){C0[r]-=dl;C1[r]-=dl;} \
        const float f=__builtin_amdgcn_exp2f(-dl); l_reg*=f; { const int lx_=pg8::pg8_lane_id(); if(lx_<32)wsf[lx_]=f; } resc=true; } } \
    SBAR(); \
    GAPB(o[0]=__builtin_amdgcn_mfma_f32_32x32x16_bf16(PAF(0),VFR(0),o[0],0,0,0), C0,0); \
    GAPB(o[1]=__builtin_amdgcn_mfma_f32_32x32x16_bf16(PAF(0),VFR(4),o[1],0,0,0), C0,4); \
    KRD(GL,0); GAPB(o[0]=__builtin_amdgcn_mfma_f32_32x32x16_bf16(PAF(1),VFR(1),o[0],0,0,0), C0,8); \
    KRD(GL,1); GAPB(o[1]=__builtin_amdgcn_mfma_f32_32x32x16_bf16(PAF(1),VFR(5),o[1],0,0,0), C0,12); \
    KRD(GL,2); GAPB(o[0]=__builtin_amdgcn_mfma_f32_32x32x16_bf16(PAF(2),VFR(2),o[0],0,0,0), C1,0); \
    KRD(GL,3); GAPB(o[1]=__builtin_amdgcn_mfma_f32_32x32x16_bf16(PAF(2),VFR(6),o[1],0,0,0), C1,4); \
    GAPB(o[0]=__builtin_amdgcn_mfma_f32_32x32x16_bf16(PAF(3),VFR(3),o[0],0,0,0), C1,8); \
    GAPB(o[1]=__builtin_amdgcn_mfma_f32_32x32x16_bf16(PAF(3),VFR(7),o[1],0,0,0), C1,12); \
    }while(0)
  int t=1;
  #define ENDW(tt) do{ if((tt)+3<NT){WAIT_BAR(2);} else if((tt)+2<NT){WAIT_BAR(1);} else {WAIT_BAR(0);} }while(0)
  for(;t<5&&t+1<NT;t+=2){
    STEP(pB0,pB1,pA0,pA1,t,(t+3<NT),(t+1<NT),(t+1<NT));       ENDW(t);   RESC(); ROT();
    STEP(pA0,pA1,pB0,pB1,t+1,(t+4<NT),(t+2<NT),(t+2<NT));     ENDW(t+1); RESC(); ROT();
  }
  #undef CMASK
  #define CMASK(P0,P1,t) do{}while(0)
  for(;t+5<NT;t+=2){
    STEP(pB0,pB1,pA0,pA1,t,true,true,true);     WAIT_BAR(2); RESC(); ROT();
    STEP(pA0,pA1,pB0,pB1,t+1,true,true,true);   WAIT_BAR(2); RESC(); ROT();
  }
  for(;t+1<NT;t+=2){
    STEP(pB0,pB1,pA0,pA1,t,(t+3<NT),(t+1<NT),(t+1<NT));       ENDW(t);   RESC(); ROT();
    STEP(pA0,pA1,pB0,pB1,t+1,(t+4<NT),(t+2<NT),(t+2<NT));     ENDW(t+1); RESC(); ROT();
  }
  #undef CMASK
  #define CMASK(P0,P1,t) do{int jb_=3-(t); if(jb_>=0)cmask(P0,P1,jb_,qrel,hi);}while(0)
  STEP(pB0,pB1,pA0,pA1,NT-1,false,false,false); RESC();
  { float sacc=pB0[0]+pB0[1]; _Pragma("unroll") for(int r=2;r<16;++r)sacc+=pB0[r]; _Pragma("unroll") for(int r=0;r<16;++r)sacc+=pB1[r]; l_reg+=sacc;
    pw0=(u32x4){PKW(pB0,0),PKW(pB0,2),PKW(pB0,4),PKW(pB0,6)};pw1=(u32x4){PKW(pB0,8),PKW(pB0,10),PKW(pB0,12),PKW(pB0,14)};pw2=(u32x4){PKW(pB1,0),PKW(pB1,2),PKW(pB1,4),PKW(pB1,6)};pw3=(u32x4){PKW(pB1,8),PKW(pB1,10),PKW(pB1,12),PKW(pB1,14)};
    SBAR(); const int ld_=pg8::pg8_lane_id(); const int vb0=(int)(lds0+LDS_V)+((ld_>>4)&1)*32+(ld_&3)*8+(4*(ld_>>5)+((ld_&15)>>2))*64; pv(o,vb0+sl_cur,PAF(0),PAF(1),PAF(2),PAF(3)); }
  #undef PKW
  #undef PAF
  #undef VFR
  #undef PIN
  #undef MX3
  #undef GAPA
  #undef GAPB
  #undef EX
  #undef VRD
  #undef KRD
  #undef STEP
  #undef ENDW
  {auto rr=__builtin_amdgcn_permlane32_swap(__float_as_uint(l_reg),__float_as_uint(l_reg),false,false);l_reg=__uint_as_float(rr[0])+__uint_as_float(rr[1]);}
  const int le_=pg8::pg8_lane_id(),r32e=le_&31,hie=le_>>5;
  if(hie==0)wsf[32+r32e]=l_reg;asm volatile("s_waitcnt lgkmcnt(0)":::"memory");
  float rli[16];
  #pragma unroll
  for(int r=0;r<16;++r)rli[r]=__builtin_amdgcn_rcpf(wsf[32+crow(r,hie)]);
  bf16*Ow=O+(rowbase+q0+wid*QBLK)*DM+h*D;
  { bf16*stg=(bf16*)(shm+LDS_OST)+wid*2048;
    #pragma unroll
    for(int r=0;r<16;++r){const int orow=crow(r,hie);
      #pragma unroll
      for(int d0=0;d0<2;++d0)stg[orow*64+d0*32+r32e]=__float2bfloat16(o[d0][r]*rli[r]);}
    asm volatile("s_waitcnt lgkmcnt(0)":::"memory");
    #pragma unroll
    for(int i=0;i<4;++i){const int row=i*8+(le_>>3),ch=le_&7; const u32x4 v=*(const u32x4*)(stg+row*64+ch*8); ATTN_STORE16(Ow+(long)row*DM+ch*8,v);} }
  asm volatile("s_waitcnt lgkmcnt(0)\n\ts_barrier":::"memory");
  #undef DMA_K
  #undef DMA_V
  #undef CMASK
  #undef START
  #undef RESC
  #undef ROT
  #undef CINIT
  #undef CINITH
}
constexpr int ATTN_LDS_BYTES=LDS_BYTES;
struct AttnTensors { const bf16* Q; const bf16* K; const bf16* V; bf16* O; };
struct AttnUnit { int bh; int qb; };
__device__ __forceinline__ void attn_phase(char*lds,const AttnTensors&T,const float*logft,__attribute__((address_space(3))) float*cum,__attribute__((address_space(3))) float*part,int v,int G,const int wid){
  typedef float f4 __attribute__((ext_vector_type(4)));
  for(int pb=v;pb<BATCH*NHEAD*4;pb+=G){
    const int bh=pb>>2,s=pb&3;
    { const int lane=pg8::pg8_lane_id(),tid=wid*64+lane;
      const f4*p=(const f4*)(logft+(size_t)bh*SEQ)+2*tid; const f4 a=p[0],b=p[1];
      float w[8]; w[0]=a.x; w[1]=w[0]+a.y; w[2]=w[1]+a.z; w[3]=w[2]+a.w; w[4]=w[3]+b.x; w[5]=w[4]+b.y; w[6]=w[5]+b.z; w[7]=w[6]+b.w;
      float incl=w[7];
      #pragma unroll
      for(int o=1;o<64;o<<=1){ const float t_=__builtin_bit_cast(float,__builtin_amdgcn_ds_bpermute((lane-o)*4,__builtin_bit_cast(int,incl))); if(lane>=o)incl+=t_; }
      if(lane==63)part[wid]=incl;
      __syncthreads();
      float base=incl-w[7];
      #pragma unroll
      for(int k=0;k<8;++k) if(k<wid) base+=part[k];
      #pragma unroll
      for(int k=0;k<8;++k) cum[8*tid+k]=w[k]+base;
      __syncthreads(); }
    #pragma unroll 1
    for(int i=0;i<4;++i){ const int qb=(i==0)?s:(i==1)?7-s:(i==2)?8+s:15-s; attn_unit<8>(bh/NHEAD,bh%NHEAD,qb,T.Q,T.K,T.V,T.O,lds,(lds_cfptr)cum,wid); }
    __syncthreads();
  }
}
#undef SBAR
#undef WAIT_BAR
}

constexpr int NWAVES = 8;
constexpr int D = 1024, NB = 4, S = 4096, M = NB * S, FF = 3584, NE = 8, NH = 16;
constexpr int NMOD = 6 * D;
constexpr float C2 = 0.125f * 1.4426950408889634f;
constexpr float LOG2E = 1.4426950408889634f;
constexpr float RMS_EPS = 1e-6f;
constexpr int ECAP = 16384;

constexpr size_t MiB = 1u << 20;
constexpr size_t WS_CTL = 0, CTL_ZERO_BYTES = 1 * MiB;
constexpr size_t WS_MOD = 1 * MiB;
constexpr size_t WS_WFT = 1 * MiB + 512 * 1024;
constexpr size_t WS_LIST = 2 * MiB, WS_WL = 2 * MiB + 512 * 1024;
constexpr size_t WS_LOGFT = 3 * MiB;
constexpr size_t WS_WFOXIN = 4 * MiB, WS_WFOXOUT = 10 * MiB, WS_WSWAIN = 12 * MiB, WS_WSWAOUT = 15 * MiB, WS_WGU = 17 * MiB, WS_WDN = 31 * MiB;
constexpr size_t WS_WMGU = 38 * MiB, WS_WMDN = 94 * MiB;
constexpr size_t WS_XA = 122 * MiB;
constexpr size_t WS_YS = 186 * MiB;
constexpr size_t WS_XN = 250 * MiB;
constexpr size_t WS_QO = 282 * MiB, WS_K = 314 * MiB, WS_V = 346 * MiB;
constexpr size_t WS_ACT = 378 * MiB;
constexpr size_t WS_XS = 250 * MiB;
constexpr size_t WS_ACT2 = 378 * MiB;
constexpr size_t WS_END = 500 * MiB;
constexpr float WSC_GU = 64.f, WSC_DN = 128.f;
constexpr int CW_TMO = 0, CW_CODE = 1, CW_BAR = 4096, CW_CNT = 16384;
constexpr int RING_OFF = 0, RING_BYTES = 131072;
constexpr int LDSCTL_OFF = RING_BYTES, MISC_OFF = LDSCTL_OFF + 320;
constexpr int TAB_OFF = MISC_OFF + 128;
constexpr int RT_OFF = TAB_OFF + 128;
constexpr int LDS_BYTES = 147456;
static_assert(RT_OFF + 128 <= LDS_BYTES, "LDS map");

#define GAS __attribute__((address_space(1)))
#define LAS __attribute__((address_space(3)))
typedef unsigned short bf16;
typedef unsigned v4u __attribute__((ext_vector_type(4)));
typedef float f32x4 __attribute__((ext_vector_type(4)));
typedef short bf16x8 __attribute__((ext_vector_type(8)));
typedef GAS unsigned gu32;
typedef GAS unsigned long long gu64;
#define RLX_AGENT __ATOMIC_RELAXED, __HIP_MEMORY_SCOPE_AGENT
#define LDS_WAIT() asm volatile("s_waitcnt lgkmcnt(0)" ::: "memory")
#define VM_WAIT() asm volatile("s_waitcnt vmcnt(0)" ::: "memory")
__device__ __forceinline__ unsigned long long rt() { return __builtin_amdgcn_s_memrealtime(); }
__device__ __forceinline__ unsigned f2bf(float f) { unsigned u = __builtin_bit_cast(unsigned, f); return (u + 0x7fffu + ((u >> 16) & 1u)) >> 16; }
__device__ __forceinline__ unsigned pk2(float lo, float hi) { return f2bf(lo) | (f2bf(hi) << 16); }
#define XB_TMO      128
#define XB_XCNT(j)  (256  + 64 * (j))
#define XB_XSUB(j)  (1280 + 64 * (j))
#define XB_XGEN(j)  (2304 + 64 * (j))
#define XB_TOP      3328
#define XB_TOPGEN   3392
#define XCD_BAR_WORDS 3456
#define XB_SPIN_CAP (1u << 18)

__device__ __forceinline__ unsigned xb_ld(unsigned* p)              { return __hip_atomic_load(p, __ATOMIC_RELAXED, __HIP_MEMORY_SCOPE_AGENT); }
__device__ __forceinline__ unsigned xb_add(unsigned* p, unsigned v) { return __hip_atomic_fetch_add(p, v, __ATOMIC_RELAXED, __HIP_MEMORY_SCOPE_AGENT); }
__device__ __forceinline__ unsigned xb_xcc_id() { return (unsigned)__builtin_amdgcn_s_getreg((3 << 11) | 20) & 0xFu; }
#define XB_SPIN(cond, bar) do { unsigned _sp = 0; while (cond) { __builtin_amdgcn_s_sleep(1); \
    if ((++_sp & 255u) == 0u) { if (xb_ld(&(bar)[XB_TMO])) break; if (_sp > XB_SPIN_CAP) { atomicAdd(&(bar)[XB_TMO], 1u); break; } } } } while (0)

struct XcdBarrier {
    unsigned* bar; unsigned x;
    volatile LAS unsigned* st;
};

__device__ __forceinline__ XcdBarrier xcd_barrier_post(unsigned* bar, volatile LAS unsigned* st, const bool xb_leader) {
    XcdBarrier b; b.bar = bar; b.x = xb_xcc_id(); b.st = st;
    if (xb_leader) (void)xb_add(&bar[XB_XCNT(b.x)], 1u);
    return b;
}
__device__ __forceinline__ void xcd_barrier_complete(unsigned* bar, unsigned x, unsigned& nloc, unsigned& nx) {
    const unsigned G = gridDim.x * gridDim.y * gridDim.z;
    unsigned sum, cnt, mine, sp = 0u;
    for (;;) {
        sum = 0u; cnt = 0u; mine = 0u;
#pragma unroll
        for (unsigned j = 0; j < 16; ++j) { const unsigned c = xb_ld(&bar[XB_XCNT(j)]); sum += c; cnt += (c > 0u) ? 1u : 0u; mine = (j == x) ? c : mine; }
        if (sum == G) break;
        __builtin_amdgcn_s_sleep(1);
        if ((++sp & 255u) == 0u) { if (xb_ld(&bar[XB_TMO])) break; if (sp > XB_SPIN_CAP) { atomicAdd(&bar[XB_TMO], 1u); break; } }
    }
    nloc = mine > 0u ? mine : 1u; nx = cnt > 0u ? cnt : 1u;
}

__device__ __forceinline__ void xcd_barrier(const XcdBarrier& b, const bool xb_leader) {
    asm volatile("s_waitcnt vmcnt(0)" ::: "memory");
    __syncthreads();
    if (xb_leader) {
        unsigned* bar = b.bar;
        __builtin_amdgcn_s_waitcnt(0);
        unsigned nloc = b.st[0], nx = b.st[1];
        if (nloc == 0u) { xcd_barrier_complete(bar, b.x, nloc, nx); b.st[0] = nloc; b.st[1] = nx; }
        const unsigned old = xb_add(&bar[XB_XSUB(b.x)], 1u);
        const unsigned gen = old / nloc;
        if (old + 1u == (gen + 1u) * nloc) {
            __builtin_amdgcn_fence(__ATOMIC_RELEASE, "agent");
            asm volatile("s_waitcnt vmcnt(0)" ::: "memory");
            const unsigned og = xb_add(&bar[XB_TOP], 1u);
            const unsigned tg = og / nx;
            if (og + 1u == (tg + 1u) * nx) xb_add(&bar[XB_TOPGEN], 1u);
            else XB_SPIN(xb_ld(&bar[XB_TOPGEN]) == tg, bar);
            __builtin_amdgcn_fence(__ATOMIC_ACQUIRE, "agent");
            xb_add(&bar[XB_XGEN(b.x)], 1u);
            asm volatile("s_waitcnt vmcnt(0)" ::: "memory");
        } else {
            XB_SPIN(xb_ld(&bar[XB_XGEN(b.x)]) == gen, bar);
            __builtin_amdgcn_fence(__ATOMIC_ACQUIRE, "agent");
            asm volatile("s_waitcnt vmcnt(0)" ::: "memory");
        }
    }
    __syncthreads();
}

struct Frame {
    LAS unsigned char* lds;
    volatile LAS unsigned* MISC;
    gu32* ctl;
    unsigned char* ws;
    int wave;
    int vcu, G;
};
struct Args { const float* in[20]; float* out; unsigned char* ws; int ph_lo, ph_hi; };

__device__ __forceinline__ float wave_sum(float v) {
#pragma unroll
    for (int o = 1; o < 64; o <<= 1) v += __shfl_xor(v, o);
    return v;
}
__device__ __forceinline__ float bf_lo(unsigned w) { return __uint_as_float(w << 16); }
__device__ __forceinline__ float bf_hi(unsigned w) { return __uint_as_float(w & 0xffff0000u); }

__device__ __forceinline__ void tr_item(const float* W, int ld, int K, int nblk, int item, bf16* WT, bool gu, LAS float* scr, int lane) {
    const int kb = item / nblk, nb = item % nblk, k0 = 64 * kb, n0 = 32 * nb;
    int drow0 = n0;
    if (gu) { const int bj = n0 / FF, j = n0 - bj * FF; drow0 = 256 * (j / 128) + 128 * bj + (j % 128); }
#pragma unroll 8
    for (int i = 0; i < 32; ++i) { const int kk = 2 * i + (lane >> 5); scr[kk * 33 + (lane & 31)] = W[(size_t)(k0 + kk) * ld + n0 + (lane & 31)]; }
    LDS_WAIT(); asm volatile("" ::: "memory");
    const int c = lane & 7;
#pragma unroll
    for (int j = 0; j < 4; ++j) { const int n = (lane >> 3) + 8 * j; const LAS float* s = scr + (8 * c) * 33 + n;
        v4u o; o.x = pk2(s[0 * 33], s[1 * 33]); o.y = pk2(s[2 * 33], s[3 * 33]); o.z = pk2(s[4 * 33], s[5 * 33]); o.w = pk2(s[6 * 33], s[7 * 33]);
        *(GAS v4u*)(WT + (size_t)(drow0 + n) * K + k0 + 8 * c) = o; }
    LDS_WAIT(); asm volatile("" ::: "memory");
}
__device__ __forceinline__ void tr_item8(const float* W, int ld, int K, int nblk, int item, unsigned char* WT, bool gu, float scale, LAS float* scr, int lane) {
    const int kb = item / nblk, nb = item % nblk, k0 = 64 * kb, n0 = 32 * nb;
    int drow0 = n0;
    if (gu) { const int bj = n0 / FF, j = n0 - bj * FF; drow0 = 256 * (j / 128) + 128 * bj + (j % 128); }
#pragma unroll 8
    for (int i = 0; i < 32; ++i) { const int kk = 2 * i + (lane >> 5); scr[kk * 33 + (lane & 31)] = W[(size_t)(k0 + kk) * ld + n0 + (lane & 31)] * scale; }
    LDS_WAIT(); asm volatile("" ::: "memory");
    const int c = lane & 3;
#pragma unroll
    for (int j = 0; j < 2; ++j) { const int n = (lane >> 2) + 16 * j; const LAS float* sp = scr + (16 * c) * 33 + n;
        v4u o; o.x = pg8::cvt_pk4_fp8(sp[0 * 33], sp[1 * 33], sp[2 * 33], sp[3 * 33]); o.y = pg8::cvt_pk4_fp8(sp[4 * 33], sp[5 * 33], sp[6 * 33], sp[7 * 33]);
        o.z = pg8::cvt_pk4_fp8(sp[8 * 33], sp[9 * 33], sp[10 * 33], sp[11 * 33]); o.w = pg8::cvt_pk4_fp8(sp[12 * 33], sp[13 * 33], sp[14 * 33], sp[15 * 33]);
        *(GAS v4u*)(WT + (size_t)(drow0 + n) * K + k0 + 16 * c) = o; }
    LDS_WAIT(); asm volatile("" ::: "memory");
}
__device__ __forceinline__ void p0_prologue(Frame& F, const Args& a) {
    const int lane = pg8::pg8_lane_id(), tid = F.wave * 64 + lane; (void)tid;
    const float* c_in = a.in[1]; const float* w_ada = a.in[2]; const float* b_ada = a.in[3];
    float* MOD = (float*)(F.ws + WS_MOD);
    LAS float* sc = (LAS float*)(F.lds + RING_OFF + 96 * 1024);
    LAS float* red = (LAS float*)(F.lds + RING_OFF + 112 * 1024);
    for (int i = tid; i < NB * D; i += NWAVES * 64) { const float v = c_in[i]; sc[i] = v / (1.f + __expf(-v)); }
    __syncthreads();
    for (int item = blockIdx.x; item < 2 * (NMOD / 32); item += F.G) {
        const int l = item / (NMOD / 32), n0 = (item % (NMOD / 32)) * 32, col = lane & 31, kpar = lane >> 5;
        const float* wp = w_ada + (size_t)l * D * NMOD + n0 + col;
        float a0 = 0.f, a1 = 0.f, a2 = 0.f, a3 = 0.f;
#pragma unroll 8
        for (int i = 0; i < 64; ++i) { const int k = 128 * F.wave + 2 * i + kpar; const float wv = wp[(size_t)k * NMOD];
            a0 += sc[k] * wv; a1 += sc[D + k] * wv; a2 += sc[2 * D + k] * wv; a3 += sc[3 * D + k] * wv; }
        a0 += __shfl_xor(a0, 32); a1 += __shfl_xor(a1, 32); a2 += __shfl_xor(a2, 32); a3 += __shfl_xor(a3, 32);
        if (lane < 32) { red[(F.wave * 4 + 0) * 32 + col] = a0; red[(F.wave * 4 + 1) * 32 + col] = a1; red[(F.wave * 4 + 2) * 32 + col] = a2; red[(F.wave * 4 + 3) * 32 + col] = a3; }
        __syncthreads();
        if (tid < 128) { const int b = tid >> 5, cc = tid & 31; float s = 0.f;
#pragma unroll
            for (int w = 0; w < 8; ++w) s += red[(w * 4 + b) * 32 + cc];
            MOD[(size_t)(l * NB + b) * NMOD + n0 + cc] = s + b_ada[l * NMOD + n0 + cc]; }
        __syncthreads();
    }
    { bf16* WFT = (bf16*)(F.ws + WS_WFT); const float* w = a.in[7];
      for (int i = blockIdx.x * (NWAVES * 64) + tid; i < 16 * D; i += F.G * NWAVES * 64) { const int hh = i & 15, k = i >> 4; WFT[hh * D + k] = (bf16)f2bf(w[(size_t)k * (3 * D + 16) + 3 * D + hh]); } }
    LAS float* scr = (LAS float*)(F.lds + RING_OFF + F.wave * 8448);
    const int gw = F.vcu * NWAVES + F.wave, NGW = F.G * NWAVES;
    constexpr int I_FI = 16 * 96, I_FO = 16 * 32, I_SI = 16 * 48, I_SO = 16 * 32, I_GU = 16 * 224, I_DN = 56 * 32;
    constexpr int NITEMS = I_FI + I_FO + I_SI + I_SO + I_GU + I_DN + NE * (I_GU + I_DN);
    for (int it = gw; it < NITEMS; it += NGW) {
        int r = it;
        if (r < I_FI) { tr_item(a.in[7], 3 * D + 16, D, 96, r, (bf16*)(F.ws + WS_WFOXIN), false, scr, lane); continue; } r -= I_FI;
        if (r < I_FO) { tr_item(a.in[9], D, D, 32, r, (bf16*)(F.ws + WS_WFOXOUT), false, scr, lane); continue; } r -= I_FO;
        if (r < I_SI) { tr_item(a.in[10], D + 512, D, 48, r, (bf16*)(F.ws + WS_WSWAIN), false, scr, lane); continue; } r -= I_SI;
        if (r < I_SO) { tr_item(a.in[12], D, D, 32, r, (bf16*)(F.ws + WS_WSWAOUT), false, scr, lane); continue; } r -= I_SO;
        if (r < I_GU) { tr_item(a.in[14], 2 * FF, D, 224, r, (bf16*)(F.ws + WS_WGU), true, scr, lane); continue; } r -= I_GU;
        if (r < I_DN) { tr_item(a.in[15], D, FF, 32, r, (bf16*)(F.ws + WS_WDN), false, scr, lane); continue; } r -= I_DN;
        if (r < NE * I_GU) { const int e = r / I_GU, rr = r % I_GU; tr_item8(a.in[18] + (size_t)e * D * 2 * FF, 2 * FF, D, 224, rr, F.ws + WS_WMGU + (size_t)e * 2 * FF * D, true, WSC_GU, scr, lane); continue; } r -= NE * I_GU;
        { const int e = r / I_DN, rr = r % I_DN; tr_item8(a.in[19] + (size_t)e * FF * D, D, FF, 32, rr, F.ws + WS_WMDN + (size_t)e * D * FF, false, WSC_DN, scr, lane); }
    }
}

__device__ __forceinline__ void norm_mod_rows(Frame& F, const float* xin, const float* g, const float* shift, const float* scale, bf16* XN) {
    const int lane = pg8::pg8_lane_id(), tid = F.wave * 64 + lane; (void)tid;
    const int gw = F.vcu * NWAVES + F.wave, NGW = F.G * NWAVES;
    for (int rg = gw; rg < M / 8; rg += NGW) {
        const int row0 = rg * 8, b = row0 / S;
        f32x4 gs[4], sh[4];
#pragma unroll
        for (int j = 0; j < 4; ++j) { const f32x4 gv = ((const GAS f32x4*)g)[lane + 64 * j], sv = ((const GAS f32x4*)(scale + (size_t)b * NMOD))[lane + 64 * j];
            gs[j] = gv * (sv + 1.0f); sh[j] = ((const GAS f32x4*)(shift + (size_t)b * NMOD))[lane + 64 * j]; }
#pragma unroll 2
        for (int r = 0; r < 8; ++r) {
            const GAS f32x4* xr = (const GAS f32x4*)(xin + (size_t)(row0 + r) * D) + lane;
            f32x4 v[4]; float s = 0.f;
#pragma unroll
            for (int j = 0; j < 4; ++j) { v[j] = xr[64 * j]; s += (v[j].x * v[j].x + v[j].y * v[j].y) + (v[j].z * v[j].z + v[j].w * v[j].w); }
            const float rstd = rsqrtf(wave_sum(s) * (1.f / D) + RMS_EPS);
            GAS unsigned long long* o8 = (GAS unsigned long long*)(XN + (size_t)(row0 + r) * D) + lane;
#pragma unroll
            for (int j = 0; j < 4; ++j) { const f32x4 y = v[j] * rstd * gs[j] + sh[j];
                o8[64 * j] = (unsigned long long)pg8::cvt_pk_bf16(y.x, y.y) | ((unsigned long long)pg8::cvt_pk_bf16(y.z, y.w) << 32); }
        }
    }
}
__device__ __forceinline__ void fgate_groups(Frame& F, const bf16* XN, const bf16* WFT, const float* b_f, float* LOGFT) {
    const int lane = pg8::pg8_lane_id(), tid = F.wave * 64 + lane; (void)tid;
    const int gw = F.vcu * NWAVES + F.wave, NGW = F.G * NWAVES, fr = lane & 15, fq = lane >> 4;
    for (int grp = gw; grp < M / 16; grp += NGW) {
        const int row0 = grp * 16;
        const bf16* ap = XN + (size_t)(row0 + fr) * D + 8 * fq; const bf16* wp = WFT + (size_t)fr * D + 8 * fq;
        f32x4 acc = (f32x4){0.f, 0.f, 0.f, 0.f};
#pragma unroll 8
        for (int kk = 0; kk < 32; ++kk) { const bf16x8 xv = *(const GAS bf16x8*)(ap + 32 * kk), wv = *(const GAS bf16x8*)(wp + 32 * kk);
            acc = __builtin_amdgcn_mfma_f32_16x16x32_bf16(wv, xv, acc, 0, 0, 0); }
        const int row = row0 + fr, b = row / S, s = row % S;
#pragma unroll
        for (int r = 0; r < 4; ++r) { const int hh = 4 * fq + r; const float z = acc[r] + b_f[hh];
            const float ls = fminf(z, 0.f) - log1pf(__expf(-fabsf(z)));
            LOGFT[(size_t)(b * NH + hh) * S + s] = ls * LOG2E; }
    }
}
__device__ __forceinline__ void block_scan4096(Frame& F, const float* src, LAS float* cum, LAS float* part) {
    const int lane = pg8::pg8_lane_id(), tid = F.wave * 64 + lane; (void)tid;
    const GAS f32x4* p = (const GAS f32x4*)src + 2 * tid;
    const f32x4 a = p[0], b = p[1];
    float v[8]; v[0] = a.x; v[1] = v[0] + a.y; v[2] = v[1] + a.z; v[3] = v[2] + a.w; v[4] = v[3] + b.x; v[5] = v[4] + b.y; v[6] = v[5] + b.z; v[7] = v[6] + b.w;
    float incl = v[7];
#pragma unroll
    for (int o = 1; o < 64; o <<= 1) { const float t = __shfl_up(incl, o); if (lane >= o) incl += t; }
    if (lane == 63) part[F.wave] = incl;
    __syncthreads();
    float base = incl - v[7];
#pragma unroll
    for (int w = 0; w < 8; ++w) if (w < F.wave) base += part[w];
#pragma unroll
    for (int i = 0; i < 8; ++i) cum[8 * tid + i] = v[i] + base;
    __syncthreads();
}
__device__ __forceinline__ void simple_attn_row_init(const bf16* qrow, unsigned (&q2)[32]) {
#pragma unroll
    for (int i = 0; i < 8; ++i) { const v4u t = *(const GAS v4u*)(qrow + 8 * i); q2[4 * i] = t.x; q2[4 * i + 1] = t.y; q2[4 * i + 2] = t.z; q2[4 * i + 3] = t.w; }
}
__device__ __forceinline__ void simple_kv_tile_load(const bf16* kbase, const bf16* vbase, size_t pitch, LAS unsigned char* reg, int lane) {
    const int key = lane >> 1, half = lane & 1;
#pragma unroll
    for (int i = 0; i < 4; ++i) { *(LAS v4u*)(reg + key * 128 + half * 64 + 16 * i) = *(const GAS v4u*)(kbase + (size_t)key * pitch + half * 32 + 8 * i);
        *(LAS v4u*)(reg + 4096 + key * 128 + half * 64 + 16 * i) = *(const GAS v4u*)(vbase + (size_t)key * pitch + half * 32 + 8 * i); }
    LDS_WAIT(); __builtin_amdgcn_wave_barrier(); asm volatile("" ::: "memory");
}
__device__ __forceinline__ float simple_dot(const unsigned (&q2)[32], const LAS unsigned char* krow) {
    float s = 0.f;
#pragma unroll
    for (int i = 0; i < 8; ++i) { const v4u t = *(const LAS v4u*)(krow + 16 * i);
        s += bf_lo(q2[4 * i]) * bf_lo(t.x) + bf_hi(q2[4 * i]) * bf_hi(t.x); s += bf_lo(q2[4 * i + 1]) * bf_lo(t.y) + bf_hi(q2[4 * i + 1]) * bf_hi(t.y);
        s += bf_lo(q2[4 * i + 2]) * bf_lo(t.z) + bf_hi(q2[4 * i + 2]) * bf_hi(t.z); s += bf_lo(q2[4 * i + 3]) * bf_lo(t.w) + bf_hi(q2[4 * i + 3]) * bf_hi(t.w); }
    return s;
}
__device__ __forceinline__ void simple_pv(float (&acc)[64], float al, float p, const LAS unsigned char* vrow) {
#pragma unroll
    for (int i = 0; i < 8; ++i) { const v4u t = *(const LAS v4u*)(vrow + 16 * i);
        acc[8 * i + 0] = acc[8 * i + 0] * al + p * bf_lo(t.x); acc[8 * i + 1] = acc[8 * i + 1] * al + p * bf_hi(t.x);
        acc[8 * i + 2] = acc[8 * i + 2] * al + p * bf_lo(t.y); acc[8 * i + 3] = acc[8 * i + 3] * al + p * bf_hi(t.y);
        acc[8 * i + 4] = acc[8 * i + 4] * al + p * bf_lo(t.z); acc[8 * i + 5] = acc[8 * i + 5] * al + p * bf_hi(t.z);
        acc[8 * i + 6] = acc[8 * i + 6] * al + p * bf_lo(t.w); acc[8 * i + 7] = acc[8 * i + 7] * al + p * bf_hi(t.w); }
}
__device__ __forceinline__ void simple_store_row(bf16* orow, const float (&acc)[64], float inv) {
#pragma unroll
    for (int i = 0; i < 8; ++i) { v4u t; t.x = pg8::cvt_pk_bf16(acc[8 * i] * inv, acc[8 * i + 1] * inv); t.y = pg8::cvt_pk_bf16(acc[8 * i + 2] * inv, acc[8 * i + 3] * inv);
        t.z = pg8::cvt_pk_bf16(acc[8 * i + 4] * inv, acc[8 * i + 5] * inv); t.w = pg8::cvt_pk_bf16(acc[8 * i + 6] * inv, acc[8 * i + 7] * inv); *(GAS v4u*)(orow + 8 * i) = t; }
}
__device__ __forceinline__ void fox_attn_simple(Frame& F, const bf16* Q, const bf16* K, const bf16* V, bf16* O, const float* LOGFT) {
    const int lane = pg8::pg8_lane_id(), tid = F.wave * 64 + lane; (void)tid;
    LAS float* cum = (LAS float*)(F.lds + RING_OFF + 65536); LAS float* part = (LAS float*)(F.lds + RING_OFF + 65536 + 16384);
    LAS unsigned char* reg = F.lds + RING_OFF + F.wave * 8192;
    for (int pb = F.vcu; pb < 256; pb += F.G) {
        const int bh = pb >> 2, b = bh / NH, h = bh % NH;
        block_scan4096(F, LOGFT + (size_t)bh * S, cum, part);
        const int j = (pb * 8 + F.wave) & 31;
        for (int which = 0; which < 2; ++which) {
            const int qt = which ? 63 - j : j, row = qt * 64 + lane;
            unsigned q2[32]; simple_attn_row_init(Q + (size_t)(b * S + row) * D + h * 64, q2);
            float acc[64];
#pragma unroll
            for (int d = 0; d < 64; ++d) acc[d] = 0.f;
            float m = -INFINITY, l = 0.f; const float cq = cum[row];
            for (int kt = 0; kt < 2 * qt + 2; ++kt) {
                __builtin_amdgcn_wave_barrier(); asm volatile("" ::: "memory");
                simple_kv_tile_load(K + (size_t)(b * S + kt * 32) * D + h * 64, V + (size_t)(b * S + kt * 32) * D + h * 64, D, reg, lane);
                for (int jj = 0; jj < 32; ++jj) { const int key = kt * 32 + jj;
                    const float s = simple_dot(q2, reg + jj * 128) + cq - cum[key];
                    if (key <= row) { const float mn = fmaxf(m, s), al = __builtin_amdgcn_exp2f(m - mn), p = __builtin_amdgcn_exp2f(s - mn); l = l * al + p; m = mn; simple_pv(acc, al, p, reg + 4096 + jj * 128); } }
            }
            simple_store_row(O + (size_t)(b * S + row) * D + h * 64, acc, 1.f / l);
        }
        __syncthreads();
    }
}
__device__ __forceinline__ int t5_bucket(int rel) {
    const int n = rel < 0 ? -rel : rel;
    const int v = n < 8 ? n : 8 + (n >= 12) + (n >= 16) + (n >= 23) + (n >= 32) + (n >= 46) + (n >= 64) + (n >= 91);
    return (rel > 0 ? 16 : 0) + v;
}
__device__ __forceinline__ void swa_unit(int b, int c, int hk, const attn_body::bf16* Q, const attn_body::bf16* K2, const attn_body::bf16* V2, attn_body::bf16* O, char* shm, attn_body::lds_cfptr tbl, const float* sinks, const int wid) {
    using namespace attn_body; typedef attn_body::bf16 abf;
    const int lane = pg8::pg8_lane_id(), r32 = lane & 31, hi = lane >> 5;
    const int hq = hk * 4 + (wid >> 1), qi = (wid & 1) * 32 + r32;
    const long rowq = (long)b * SEQ + c * 64;
    const abf* Qw = Q + (rowq + (wid & 1) * 32) * DM + hq * 64;
    const unsigned lds0 = (unsigned)(uintptr_t)shm;
    const int j0 = c >= 2 ? 0 : 2 - c;
#pragma unroll
    for (int j = 0; j < 3; ++j) if (j >= j0) {
        const long pos0 = (long)b * SEQ + c * 64 - 128 + 64 * j;
        glds16(K2 + (pos0 + lane) * 256 + hk * 64 + wid * 8, (unsigned)__builtin_amdgcn_readfirstlane(lds0 + LDS_K + j * SLOTB + wid * 1024));
        glds16(V2 + (pos0 + 16 * (wid & 3) + (lane >> 2)) * 256 + hk * 64 + (wid >> 2) * 32 + (lane & 3) * 8, (unsigned)__builtin_amdgcn_readfirstlane(lds0 + LDS_V + j * SLOTB + wid * 1024));
    }
    bf16x8 qr[4];
#pragma unroll
    for (int d0 = 0; d0 < 4; ++d0) qr[d0] = *reinterpret_cast<const bf16x8*>(&Qw[(long)r32 * DM + d0 * 16 + hi * 8]);
    const float sk = sinks[hq] * 1.4426950408889634f;
    asm volatile("s_waitcnt vmcnt(0) lgkmcnt(0)\n\ts_barrier" ::: "memory");
    f32x16 sc[3][2];
    const lds_cfptr tb = tbl + hq * 256 + 63 - qi + 4 * hi;
#pragma unroll
    for (int j = 0; j < 3; ++j) if (j >= j0) {
#pragma unroll
        for (int r = 0; r < 16; ++r) { const int ko = 64 * j + (r & 3) + 8 * (r >> 2); sc[j][0][r] = tb[ko]; sc[j][1][r] = tb[ko + 32]; }
        qkt(sc[j][0], sc[j][1], shm + LDS_K + j * SLOTB, qr, r32, hi);
    }
    float m = sk;
#pragma unroll
    for (int j = 0; j < 3; ++j) if (j >= j0) {
#pragma unroll
        for (int r = 0; r < 16; ++r) m = __builtin_fmaxf(m, __builtin_fmaxf(sc[j][0][r], sc[j][1][r]));
    }
    { auto rr = __builtin_amdgcn_permlane32_swap(__float_as_uint(m), __float_as_uint(m), false, false); m = __builtin_fmaxf(__uint_as_float(rr[0]), __uint_as_float(rr[1])); }
    float l = 0.f; f32x16 o[2]; o[0] = f32x16{}; o[1] = f32x16{};
    const int vb0 = (int)(lds0 + LDS_V) + ((lane >> 4) & 1) * 32 + (lane & 3) * 8 + (4 * hi + ((lane & 15) >> 2)) * 64;
#pragma unroll
    for (int j = 0; j < 3; ++j) if (j >= j0) {
#pragma unroll
        for (int r = 0; r < 16; ++r) { sc[j][0][r] = __builtin_amdgcn_exp2f(sc[j][0][r] - m); sc[j][1][r] = __builtin_amdgcn_exp2f(sc[j][1][r] - m); l += sc[j][0][r] + sc[j][1][r]; }
        u32x4 pw0, pw1, pw2, pw3;
#define SWA_PK(P, B) cvtpk_s(P[B], P[B + 1])
        pw0 = (u32x4){SWA_PK(sc[j][0], 0), SWA_PK(sc[j][0], 2), SWA_PK(sc[j][0], 4), SWA_PK(sc[j][0], 6)}; pw1 = (u32x4){SWA_PK(sc[j][0], 8), SWA_PK(sc[j][0], 10), SWA_PK(sc[j][0], 12), SWA_PK(sc[j][0], 14)};
        pw2 = (u32x4){SWA_PK(sc[j][1], 0), SWA_PK(sc[j][1], 2), SWA_PK(sc[j][1], 4), SWA_PK(sc[j][1], 6)}; pw3 = (u32x4){SWA_PK(sc[j][1], 8), SWA_PK(sc[j][1], 10), SWA_PK(sc[j][1], 12), SWA_PK(sc[j][1], 14)};
#undef SWA_PK
        pv(o, vb0 + j * SLOTB, __builtin_bit_cast(bf16x8, pw0), __builtin_bit_cast(bf16x8, pw1), __builtin_bit_cast(bf16x8, pw2), __builtin_bit_cast(bf16x8, pw3));
    }
    { auto rr = __builtin_amdgcn_permlane32_swap(__float_as_uint(l), __float_as_uint(l), false, false); l = __uint_as_float(rr[0]) + __uint_as_float(rr[1]); }
    l += __builtin_amdgcn_exp2f(sk - m);
    float* wsf = (float*)(shm + LDS_WS) + wid * 64;
    if (hi == 0) wsf[32 + r32] = l; asm volatile("s_waitcnt lgkmcnt(0)" ::: "memory");
    float rli[16];
#pragma unroll
    for (int r = 0; r < 16; ++r) rli[r] = __builtin_amdgcn_rcpf(wsf[32 + crow(r, hi)]);
    abf* Ow = O + (rowq + (wid & 1) * 32) * DM + hq * 64;
    { abf* stg = (abf*)(shm + LDS_OST) + wid * 2048;
#pragma unroll
        for (int r = 0; r < 16; ++r) { const int orow = crow(r, hi);
#pragma unroll
            for (int d0 = 0; d0 < 2; ++d0) stg[orow * 64 + d0 * 32 + r32] = __float2bfloat16(o[d0][r] * rli[r]); }
        asm volatile("s_waitcnt lgkmcnt(0)" ::: "memory");
#pragma unroll
        for (int i = 0; i < 4; ++i) { const int row = i * 8 + (lane >> 3), ch = lane & 7; const u32x4 v = *(const u32x4*)(stg + row * 64 + ch * 8); *(u32x4*)(Ow + (long)row * DM + ch * 8) = v; } }
    asm volatile("s_waitcnt lgkmcnt(0)\n\ts_barrier" ::: "memory");
}
__device__ __forceinline__ void swa_phase(char* lds, const bf16* Q, const bf16* K2, const bf16* V2, bf16* O, const float* sinks, const float* rel_bias, LAS float* tbl, int v, int G, const int wid) {
    { const int lane = pg8::pg8_lane_id(), tid = wid * 64 + lane;
      for (int i = tid; i < 16 * 256; i += NWAVES * 64) { const int hq = i >> 8, k = i & 255; tbl[i] = (k < 255) ? rel_bias[t5_bucket(k - 191) * NH + hq] * LOG2E : 0.f; } }
    __syncthreads();
    for (int item = v; item < 256; item += G) {
        const int b = item >> 6, hk = (item >> 4) & 3, c0 = (item & 15) * 4;
#pragma unroll 1
        for (int i = 0; i < 4; ++i) swa_unit(b, c0 + i, hk, (const attn_body::bf16*)Q, (const attn_body::bf16*)K2, (const attn_body::bf16*)V2, (attn_body::bf16*)O, lds, (attn_body::lds_cfptr)tbl, sinks, wid);
    }
    __syncthreads();
}
__device__ __forceinline__ void swa_attn_simple(Frame& F, const bf16* Q, const bf16* K, const bf16* V, bf16* O, const float* sinks, const float* rel_bias) {
    const int lane = pg8::pg8_lane_id(), tid = F.wave * 64 + lane; (void)tid;
    LAS unsigned char* reg = F.lds + RING_OFF + F.wave * 8192;
    LAS float* T = (LAS float*)(F.lds + RING_OFF + 65536 + F.wave * 1024);
    const int gw = F.vcu * NWAVES + F.wave, NGW = F.G * NWAVES;
    for (int ui = gw; ui < NB * 64 * NH; ui += NGW) {
        const int hq = ui % NH, c = (ui / NH) % 64, b = ui / (NH * 64), hk = hq >> 2, row = c * 64 + lane;
        __builtin_amdgcn_wave_barrier(); asm volatile("" ::: "memory");
        for (int i = lane; i < 255; i += 64) T[i] = rel_bias[t5_bucket(i - 191) * NH + hq] * LOG2E;
        unsigned q2[32]; simple_attn_row_init(Q + (size_t)(b * S + row) * D + hq * 64, q2);
        float acc[64];
#pragma unroll
        for (int d = 0; d < 64; ++d) acc[d] = 0.f;
        float m = -INFINITY, l = 0.f;
        for (int kt = 0; kt < 6; ++kt) {
            const int pos0 = 64 * c - 128 + 32 * kt; if (pos0 < 0) continue;
            __builtin_amdgcn_wave_barrier(); asm volatile("" ::: "memory");
            simple_kv_tile_load(K + (size_t)(b * S + pos0) * 256 + hk * 64, V + (size_t)(b * S + pos0) * 256 + hk * 64, 256, reg, lane);
            for (int jj = 0; jj < 32; ++jj) { const int kb = 32 * kt + jj;
                const float s = simple_dot(q2, reg + jj * 128) + T[kb + 63 - lane];
                const float mn = fmaxf(m, s), al = __builtin_amdgcn_exp2f(m - mn), p = __builtin_amdgcn_exp2f(s - mn); l = l * al + p; m = mn; simple_pv(acc, al, p, reg + 4096 + jj * 128); }
        }
        const float sk = sinks[hq] * LOG2E, mf = fmaxf(m, sk), al = __builtin_amdgcn_exp2f(m - mf);
        l = l * al + __builtin_amdgcn_exp2f(sk - mf);
        simple_store_row(O + (size_t)(b * S + row) * D + hq * 64, acc, al / l);
    }
}
__device__ __forceinline__ void route_rows(Frame& F, const float* xin, const float* g, const float* shift, const float* scale, const float* w_router, const float* b_router,
                                           unsigned char* XS, int* list, float* wl, gu32* cnt) {
    const int lane = pg8::pg8_lane_id(), tid = F.wave * 64 + lane; (void)tid;
    LAS float* wr = (LAS float*)(F.lds + RING_OFF);
    volatile LAS int* rt = (volatile LAS int*)(F.lds + RT_OFF);
    for (int i = tid; i < D * NE; i += NWAVES * 64) wr[i] = w_router[i];
    for (int blk = F.vcu; blk < M / 32; blk += F.G) {
        if (tid < 16) rt[tid] = 0;
        __syncthreads();
        const int row0 = blk * 32 + F.wave * 4, b = row0 / S;
        f32x4 gs[4], sh[4];
#pragma unroll
        for (int j = 0; j < 4; ++j) { const f32x4 gv = ((const GAS f32x4*)g)[lane + 64 * j], sv = ((const GAS f32x4*)(scale + (size_t)b * NMOD))[lane + 64 * j];
            gs[j] = gv * (sv + 1.0f); sh[j] = ((const GAS f32x4*)(shift + (size_t)b * NMOD))[lane + 64 * j]; }
        unsigned hp[4][4]; int e0[4], e1[4], p0[4], p1[4]; float w0[4];
#pragma unroll
        for (int r = 0; r < 4; ++r) {
            const GAS f32x4* xr = (const GAS f32x4*)(xin + (size_t)(row0 + r) * D) + lane;
            f32x4 v[4]; float s = 0.f;
#pragma unroll
            for (int j = 0; j < 4; ++j) { v[j] = xr[64 * j]; s += (v[j].x * v[j].x + v[j].y * v[j].y) + (v[j].z * v[j].z + v[j].w * v[j].w); }
            const float rstd = rsqrtf(wave_sum(s) * (1.f / D) + RMS_EPS);
            float lg[8];
#pragma unroll
            for (int e = 0; e < 8; ++e) lg[e] = 0.f;
#pragma unroll
            for (int j = 0; j < 4; ++j) { const f32x4 y = v[j] * rstd * gs[j] + sh[j];
                hp[r][j] = pg8::cvt_pk4_fp8(y.x, y.y, y.z, y.w);
#pragma unroll
                for (int i = 0; i < 4; ++i) { const LAS f32x4* wq = (const LAS f32x4*)(wr + (size_t)(4 * lane + 256 * j + i) * 8); const f32x4 wa = wq[0], wb = wq[1]; const float yv = y[i];
                    lg[0] += yv * wa.x; lg[1] += yv * wa.y; lg[2] += yv * wa.z; lg[3] += yv * wa.w; lg[4] += yv * wb.x; lg[5] += yv * wb.y; lg[6] += yv * wb.z; lg[7] += yv * wb.w; } }
#pragma unroll
            for (int e = 0; e < 8; ++e) lg[e] = wave_sum(lg[e]) + b_router[e];
            int i0 = 0; float v0 = lg[0];
#pragma unroll
            for (int e = 1; e < 8; ++e) if (lg[e] > v0) { v0 = lg[e]; i0 = e; }
            int i1 = 0; float v1 = -INFINITY;
#pragma unroll
            for (int e = 0; e < 8; ++e) if (e != i0 && lg[e] > v1) { v1 = lg[e]; i1 = e; }
            const float wt1 = 1.f / (1.f + __expf(v0 - v1));
            e0[r] = i0; e1[r] = i1; w0[r] = 1.f - wt1;
            int q0 = 0, q1 = 0;
            if (lane == 0) { q0 = __hip_atomic_fetch_add((LAS int*)rt + i0, 1, __ATOMIC_RELAXED, __HIP_MEMORY_SCOPE_WORKGROUP); q1 = __hip_atomic_fetch_add((LAS int*)rt + i1, 1, __ATOMIC_RELAXED, __HIP_MEMORY_SCOPE_WORKGROUP); }
            p0[r] = __builtin_amdgcn_readfirstlane(q0); p1[r] = __builtin_amdgcn_readfirstlane(q1);
        }
        __syncthreads();
        if (tid < 8) rt[8 + tid] = (int)__hip_atomic_fetch_add(cnt + 64 * tid, (unsigned)rt[tid], __ATOMIC_RELAXED, __HIP_MEMORY_SCOPE_AGENT);
        __syncthreads();
#pragma unroll
        for (int r = 0; r < 4; ++r) {
            const int tok = row0 + r;
            const int d0 = e0[r] * ECAP + rt[8 + e0[r]] + p0[r], d1 = e1[r] * ECAP + rt[8 + e1[r]] + p1[r];
            GAS unsigned* o0 = (GAS unsigned*)(XS + (size_t)d0 * D) + lane; GAS unsigned* o1 = (GAS unsigned*)(XS + (size_t)d1 * D) + lane;
#pragma unroll
            for (int j = 0; j < 4; ++j) { o0[64 * j] = hp[r][j]; o1[64 * j] = hp[r][j]; }
            if (lane == 0) { list[d0] = 2 * tok; wl[d0] = w0[r]; list[d1] = 2 * tok + 1; wl[d1] = 1.f - w0[r]; }
        }
        __syncthreads();
    }
}
__device__ __forceinline__ void final_rows(Frame& F, const float* XA, const bf16* YS, const float* gate, const float* g, float* out) {
    const int lane = pg8::pg8_lane_id(), tid = F.wave * 64 + lane; (void)tid;
    const int gw = F.vcu * NWAVES + F.wave, NGW = F.G * NWAVES;
    for (int rg = gw; rg < M / 8; rg += NGW) {
        const int row0 = rg * 8, b = row0 / S;
        f32x4 gt[4], gf[4];
#pragma unroll
        for (int j = 0; j < 4; ++j) { gt[j] = ((const GAS f32x4*)(gate + (size_t)b * NMOD))[lane + 64 * j]; gf[j] = ((const GAS f32x4*)g)[lane + 64 * j]; }
#pragma unroll 2
        for (int r = 0; r < 8; ++r) {
            const int row = row0 + r;
            const GAS f32x4* xr = (const GAS f32x4*)(XA + (size_t)row * D) + lane;
            const GAS unsigned long long* y0 = (const GAS unsigned long long*)(YS + (size_t)(2 * row) * D) + lane; const GAS unsigned long long* y1 = (const GAS unsigned long long*)(YS + (size_t)(2 * row + 1) * D) + lane;
            f32x4 v[4]; float s = 0.f;
#pragma unroll
            for (int j = 0; j < 4; ++j) { const unsigned long long a = y0[64 * j], c = y1[64 * j]; const unsigned al = (unsigned)a, ah = (unsigned)(a >> 32), cl = (unsigned)c, ch = (unsigned)(c >> 32);
                const f32x4 ys = (f32x4){bf_lo(al) + bf_lo(cl), bf_hi(al) + bf_hi(cl), bf_lo(ah) + bf_lo(ch), bf_hi(ah) + bf_hi(ch)};
                v[j] = xr[64 * j] + gt[j] * ys; s += (v[j].x * v[j].x + v[j].y * v[j].y) + (v[j].z * v[j].z + v[j].w * v[j].w); }
            const float rstd = rsqrtf(wave_sum(s) * (1.f / D) + RMS_EPS);
            GAS f32x4* o = (GAS f32x4*)(out + (size_t)row * D) + lane;
#pragma unroll
            for (int j = 0; j < 4; ++j) o[64 * j] = v[j] * rstd * gf[j];
        }
    }
}

#ifndef PROBE_REP_MASK
#define PROBE_REP_MASK 0
#endif
__global__ void __launch_bounds__(NWAVES * 64, 2) mk_fwd(Args args) {
    extern __shared__ __attribute__((aligned(16))) unsigned char lds[];
    Frame F;
    F.lds = (LAS unsigned char*)lds;
    F.MISC = (volatile LAS unsigned*)(F.lds + MISC_OFF);
    F.wave = __builtin_amdgcn_readfirstlane((int)threadIdx.x >> 6);
    F.G = gridDim.x; { const int bx = blockIdx.x; F.vcu = (F.G % 8 == 0) ? (bx % 8) * (F.G / 8) + bx / 8 : bx; }
    F.ws = args.ws; F.ctl = (gu32*)(args.ws + WS_CTL);
    for (int u = F.wave * 64 + pg8::pg8_lane_id(); u < (LDS_BYTES - LDSCTL_OFF) / 4; u += NWAVES * 64) ((LAS unsigned*)(F.lds + LDSCTL_OFF))[u] = 0u;
    __syncthreads();
    XcdBarrier bar = xcd_barrier_post((unsigned*)(F.ctl + CW_BAR), F.MISC + 8, F.wave == 0 && pg8::pg8_lane_id() == 0);
    const int lo = args.ph_lo, hi = args.ph_hi;
#define IN(k) (lo <= (k) && (k) < hi)
#define REP(k) _Pragma("unroll") for (int rep_ = 0; rep_ < (((PROBE_REP_MASK >> (k)) & 1) ? 2 : 1); ++rep_)
#define SEAM(k) do { if (IN(k) && IN((k) + 1)) xcd_barrier(bar, F.wave == 0 && pg8::pg8_lane_id() == 0); } while (0)
    unsigned char* ws = args.ws;
    const float* MOD0 = (const float*)(ws + WS_MOD); const float* MOD1 = MOD0 + NB * NMOD;
    bf16* XN = (bf16*)(ws + WS_XN); bf16* QO = (bf16*)(ws + WS_QO); bf16* KB = (bf16*)(ws + WS_K); bf16* VB = (bf16*)(ws + WS_V);
    float* XA = (float*)(ws + WS_XA); bf16* ACT = (bf16*)(ws + WS_ACT); unsigned char* XS = ws + WS_XS; unsigned char* ACT2 = ws + WS_ACT2; bf16* YS = (bf16*)(ws + WS_YS);
    float* LOGFT = (float*)(ws + WS_LOGFT); float* X2 = args.out;

    if (IN(0)) REP(0) { p0_prologue(F, args); } SEAM(0);
    if (IN(1)) REP(1) { norm_mod_rows(F, args.in[0], args.in[4], MOD0 + 0 * D, MOD0 + 1 * D, XN); } SEAM(1);
    if (IN(2)) REP(2) {
        fgate_groups(F, XN, (const bf16*)(ws + WS_WFT), args.in[8], LOGFT);
        pg8::Gemm g{XN, (const pg8::bf16_t*)(ws + WS_WFOXIN), M, 3 * D, D}; pg8::StaticOrder So; So.init(M, 3 * D, F.G, (int)blockIdx.x);
        pg8::EpiQKV<0> E{QO, (size_t)(WS_K - WS_QO) / 2, C2};
        pg8::gemm_phase<pg8::EpiQKV<0>, pg8::StaticOrder, true, true>(F.lds + RING_OFF, g, So, E, F.wave);
    } SEAM(2);
    if (IN(3)) REP(3) {
        static_assert(attn_body::ATTN_LDS_BYTES <= 96 * 1024, "attention scratch vs the cumulative-gate table");
        const attn_body::AttnTensors AT{(const attn_body::bf16*)QO, (const attn_body::bf16*)KB, (const attn_body::bf16*)VB, (attn_body::bf16*)XN};
        attn_body::attn_phase((char*)lds + RING_OFF, AT, LOGFT, (LAS float*)(F.lds + RING_OFF + 96 * 1024), (LAS float*)(F.lds + RING_OFF + 112 * 1024), F.vcu, F.G, F.wave);
    } SEAM(3);
    if (IN(4)) REP(4) {
        pg8::Gemm g{XN, (const pg8::bf16_t*)(ws + WS_WFOXOUT), M, D, D}; pg8::StaticOrder So; So.init(M, D, F.G, (int)blockIdx.x);
        pg8::EpiResid E{args.in[0], XA, MOD0 + 2 * D, D, S, NMOD};
        pg8::gemm_phase<pg8::EpiResid, pg8::StaticOrder, true, true>(F.lds + RING_OFF, g, So, E, F.wave);
    } SEAM(4);
    if (IN(5)) REP(5) { norm_mod_rows(F, XA, args.in[5], MOD0 + 3 * D, MOD0 + 4 * D, XN); } SEAM(5);
    if (IN(6)) REP(6) {
        pg8::Gemm g{XN, (const pg8::bf16_t*)(ws + WS_WGU), M, 2 * FF, D}; pg8::StaticOrder So; So.init(M, 2 * FF, F.G, (int)blockIdx.x);
        pg8::EpiSwiglu<false> E{ACT, FF, 1.f, 1.f};
        pg8::gemm_phase<pg8::EpiSwiglu<false>, pg8::StaticOrder, true, true>(F.lds + RING_OFF, g, So, E, F.wave);
    } SEAM(6);
    if (IN(7)) REP(7) {
        pg8::Gemm g{ACT, (const pg8::bf16_t*)(ws + WS_WDN), M, D, FF}; pg8::StaticOrder So; So.init(M, D, F.G, (int)blockIdx.x);
        pg8::EpiResid E{XA, X2, MOD0 + 5 * D, D, S, NMOD};
        pg8::gemm_phase<pg8::EpiResid, pg8::StaticOrder, true, true>(F.lds + RING_OFF, g, So, E, F.wave);
    } SEAM(7);
    if (IN(8)) REP(8) { norm_mod_rows(F, X2, args.in[4] + D, MOD1 + 0 * D, MOD1 + 1 * D, XN); } SEAM(8);
    if (IN(9)) REP(9) {
        pg8::Gemm g{XN, (const pg8::bf16_t*)(ws + WS_WSWAIN), M, D + 512, D}; pg8::StaticOrder So; So.init(M, D + 512, F.G, (int)blockIdx.x);
        pg8::EpiQKV<1> E{QO, (size_t)(WS_K - WS_QO) / 2, C2};
        pg8::gemm_phase<pg8::EpiQKV<1>, pg8::StaticOrder, true, true>(F.lds + RING_OFF, g, So, E, F.wave);
    } SEAM(9);
    if (IN(10)) REP(10) { swa_phase((char*)lds + RING_OFF, QO, KB, VB, XN, args.in[11], args.in[13], (LAS float*)(F.lds + RING_OFF + 96 * 1024), F.vcu, F.G, F.wave); } SEAM(10);
    if (IN(11)) REP(11) {
        pg8::Gemm g{XN, (const pg8::bf16_t*)(ws + WS_WSWAOUT), M, D, D}; pg8::StaticOrder So; So.init(M, D, F.G, (int)blockIdx.x);
        pg8::EpiResid E{X2, XA, MOD1 + 2 * D, D, S, NMOD};
        pg8::gemm_phase<pg8::EpiResid, pg8::StaticOrder, true, true>(F.lds + RING_OFF, g, So, E, F.wave);
    } SEAM(11);
    if (IN(12)) { route_rows(F, XA, args.in[5] + D, MOD1 + 3 * D, MOD1 + 4 * D, args.in[16], args.in[17], XS, (int*)(ws + WS_LIST), (float*)(ws + WS_WL), F.ctl + CW_CNT); } SEAM(12);
    if (IN(13) || IN(14)) {
        volatile LAS int* tab = (volatile LAS int*)(F.lds + TAB_OFF);
        if (F.wave == 0 && pg8::pg8_lane_id() == 0) { int accp = 0;
            for (int e = 0; e < NE; ++e) { const int n = (int)__hip_atomic_load(F.ctl + CW_CNT + 64 * e, RLX_AGENT); tab[e] = accp; accp += (n + 255) >> 8; }
            tab[8] = accp; }
        __syncthreads();
    }
    if (IN(13)) REP(13) {
        pg8::Gemm g{(const pg8::bf16_t*)XS, (const pg8::bf16_t*)(ws + WS_WMGU), M, 2 * FF, D / 2  }; pg8::MoeOrder So; So.init((const LAS int*)(F.lds + TAB_OFF), 2 * FF / 256, F.G, (int)blockIdx.x, ECAP / 256);
        pg8::EpiSwiglu<true> E{ACT2, FF, 1.f / WSC_GU, 1.f};
        pg8::gemm_phase<pg8::EpiSwiglu<true>, pg8::MoeOrder, true, true, true>(F.lds + RING_OFF, g, So, E, F.wave);
    } SEAM(13);
    if (IN(14)) REP(14) {
        pg8::Gemm g{(const pg8::bf16_t*)ACT2, (const pg8::bf16_t*)(ws + WS_WMDN), M, D, FF / 2  }; pg8::MoeOrder So; So.init((const LAS int*)(F.lds + TAB_OFF), D / 256, F.G, (int)blockIdx.x, 0);
        pg8::EpiScatter E{YS, (const int*)(ws + WS_LIST), (const float*)(ws + WS_WL), (const unsigned*)(F.ctl + CW_CNT), ECAP, 64, 1.f / WSC_DN};
        pg8::gemm_phase<pg8::EpiScatter, pg8::MoeOrder, true, true, true>(F.lds + RING_OFF, g, So, E, F.wave);
    } SEAM(14);
    if (IN(15)) REP(15) { final_rows(F, XA, YS, MOD1 + 5 * D, args.in[6], args.out); }
#undef IN
#undef SEAM
}

extern "C" void kernel_launch(void* const* d_in, const int* in_sizes, int n_in, void* d_out, int out_size, void* d_ws, size_t ws_size, hipStream_t stream) {
    static int grid = 0;
    if (grid == 0) {
        if (n_in != 20 || out_size != M * D || ws_size < WS_END) { fprintf(stderr, "kernel_launch: unexpected problem (n_in %d, out %d, ws %zu)\n", n_in, out_size, ws_size); grid = -1; return; }
        int dev = 0, cus = 0, per_cu = 0;
        if (hipGetDevice(&dev) != hipSuccess || hipDeviceGetAttribute(&cus, hipDeviceAttributeMultiprocessorCount, dev) != hipSuccess) { grid = -1; return; }
        if (hipFuncSetAttribute((const void*)mk_fwd, hipFuncAttributeMaxDynamicSharedMemorySize, LDS_BYTES) != hipSuccess) { fprintf(stderr, "kernel_launch: hipFuncSetAttribute failed\n"); grid = -1; return; }
        if (hipOccupancyMaxActiveBlocksPerMultiprocessor(&per_cu, (const void*)mk_fwd, NWAVES * 64, LDS_BYTES) != hipSuccess || per_cu < 1) { fprintf(stderr, "kernel_launch: occupancy query reports %d\n", per_cu); (void)hipGetLastError(); grid = -1; return; }
        grid = cus;
    }
    if (grid < 0) return;
    if (hipMemsetAsync((char*)d_ws + WS_CTL, 0, CTL_ZERO_BYTES, stream) != hipSuccess) return;
    Args a{};
    for (int i = 0; i < 20; ++i) a.in[i] = (const float*)d_in[i];
    a.out = (float*)d_out; a.ws = (unsigned char*)d_ws; a.ph_lo = 0; a.ph_hi = 16;
    hipLaunchKernelGGL(mk_fwd, dim3(grid), dim3(NWAVES * 64), LDS_BYTES, stream, a);
}
```
